# Optimizing an MI355X kernel written in HIP

```python
import jax, jax.numpy as jnp
from jax import lax
import numpy as np

D_MODEL = 1024
BATCH = 4
SEQ = 4096
DEPTH = 4
DEC_BATCH = 16
DEC_SEQ = 2048
PAST_LEN = 128

HEAD_DIM = 64
N_HEADS_NA = 6
N_HEADS_WIN = 6
N_KV_WIN = 2
N_HEADS_MEM = 4
D_NA = N_HEADS_NA * HEAD_DIM
D_WIN = N_HEADS_WIN * HEAD_DIM
D_KV_WIN = N_KV_WIN * HEAD_DIM
D_MEM = N_HEADS_MEM * HEAD_DIM
D_MIX = D_NA + D_WIN + D_MEM
D_IN = 4 * D_NA + 2 * D_WIN + 2 * D_KV_WIN + 2 * D_MEM
N_MEM = 256
GRID_W = 64
NA_ROWS_MAX = 8
NA_COLS = 16
NA_QCOLS = 16
NA_KCOLS = 32
WINDOW = 128
WIN_BLOCK = 128
RMS_EPS = 1e-6
NEG_INF = -1e30

kernel_name = "hymba_natten_swa_memory_encoder"


def rms_norm(x, g):
    xf = x.astype(jnp.float32)
    y = xf * lax.rsqrt(jnp.mean(xf * xf, axis=-1, keepdims=True) + RMS_EPS)
    return (y * g.astype(jnp.float32)).astype(x.dtype)


def alibi_slopes(n_heads):
    return 2.0 ** (-8.0 * jnp.arange(1, n_heads + 1, dtype=jnp.float32) / n_heads)


def neighbourhood_attention(q, k, v, rpb):
    b, t, h, d = q.shape
    rows = t // GRID_W
    kh = min(NA_ROWS_MAX, rows)
    qg = q.reshape(b, rows, GRID_W, h, d)
    kg = k.reshape(b, rows, GRID_W, h, d)
    vg = v.reshape(b, rows, GRID_W, h, d)
    r = jnp.arange(rows)
    r0 = jnp.clip(r - kh // 2, 0, rows - kh)
    row_idx = r0[:, None] + jnp.arange(kh)[None, :]
    rel_row = row_idx - r[:, None] + (NA_ROWS_MAX - 1)
    outs = []
    for c0 in range(0, GRID_W, NA_QCOLS):
        kc0 = min(max(c0 - NA_COLS // 2, 0), GRID_W - NA_KCOLS)
        qc = c0 + jnp.arange(NA_QCOLS)
        kc = kc0 + jnp.arange(NA_KCOLS)
        cs = jnp.clip(qc - NA_COLS // 2, 0, GRID_W - NA_COLS)
        col_mask = (kc[None, :] >= cs[:, None]) & (kc[None, :] < cs[:, None] + NA_COLS)
        rel_col = jnp.clip(kc[None, :] - qc[:, None] + NA_COLS - 1, 0, 2 * NA_COLS - 2)
        k_blk = jnp.take(kg[:, :, kc0:kc0 + NA_KCOLS], row_idx, axis=1)
        v_blk = jnp.take(vg[:, :, kc0:kc0 + NA_KCOLS], row_idx, axis=1)
        s = jnp.einsum("brqhd,brkwhd->brhqkw", qg[:, :, c0:c0 + NA_QCOLS], k_blk,
                       preferred_element_type=jnp.float32)
        bias = rpb[:, rel_row[:, None, :, None], rel_col[None, :, None, :]]
        bias = jnp.transpose(bias, (1, 0, 2, 3, 4)).astype(jnp.float32)
        s = s + bias[None] + jnp.where(col_mask, 0.0, NEG_INF)[:, None, :]
        p = jax.nn.softmax(s.reshape(b, rows, h, NA_QCOLS, kh * NA_KCOLS), axis=-1).reshape(s.shape)
        outs.append(jnp.einsum("brhqkw,brkwhd->brqhd", p.astype(v.dtype), v_blk))
    o = jnp.stack(outs, axis=2)
    return o.reshape(b, t, h * d)


def windowed_gqa(q, k, v, sink):
    b, t, h, d = q.shape
    kvh = k.shape[2]
    g = h // kvh
    nb = t // WIN_BLOCK
    qb = q.reshape(b, nb, WIN_BLOCK, kvh, g, d)
    pad = ((0, 0), (WIN_BLOCK, WIN_BLOCK), (0, 0), (0, 0))
    kp = jnp.pad(k, pad).reshape(b, nb + 2, WIN_BLOCK, kvh, d)
    vp = jnp.pad(v, pad).reshape(b, nb + 2, WIN_BLOCK, kvh, d)
    kb = jnp.concatenate([kp[:, :-2], kp[:, 1:-1], kp[:, 2:]], axis=2)
    vb = jnp.concatenate([vp[:, :-2], vp[:, 1:-1], vp[:, 2:]], axis=2)
    s = jnp.einsum("bnqkgd,bnskd->bnkgqs", qb, kb, preferred_element_type=jnp.float32)
    i = jnp.arange(WIN_BLOCK)
    w = jnp.arange(3 * WIN_BLOCK)
    dist = (i[:, None] - w[None, :] + WIN_BLOCK).astype(jnp.float32)
    pos_s = jnp.arange(nb)[:, None] * WIN_BLOCK - WIN_BLOCK + w[None, :]
    valid = (jnp.abs(dist) <= WINDOW)[None] & ((pos_s >= 0) & (pos_s < t))[:, None, :]
    slopes = alibi_slopes(h).reshape(kvh, g)
    s = s - slopes[:, :, None, None] * jnp.abs(dist)[None, None]
    s = jnp.where(valid[None, :, None, None], s, NEG_INF)
    sink_l = sink.astype(jnp.float32).reshape(kvh, g)[None, None, :, :, None, None]
    m = jnp.maximum(jnp.max(s, axis=-1, keepdims=True), sink_l)
    p = jnp.exp(s - m)
    denom = jnp.sum(p, axis=-1, keepdims=True) + jnp.exp(sink_l - m)
    o = jnp.einsum("bnkgqs,bnskd->bnqkgd", (p / denom).astype(v.dtype), vb)
    return o.reshape(b, t, h * d)


def memory_attention(q, km, vm):
    b, t, h, d = q.shape
    s = jnp.einsum("bthd,bmhd->bhtm", q, km, preferred_element_type=jnp.float32)
    p = jax.nn.softmax(s, axis=-1)
    o = jnp.einsum("bhtm,bmhd->bthd", p.astype(vm.dtype), vm)
    return o.reshape(b, t, h * d)


def layer(x, mem, norm_g, w_in, q_norm_g, k_norm_g, rpb, sink, mem_norm_g, w_mem_kv, w_out):
    b, t, _ = x.shape
    scale = HEAD_DIM ** -0.5
    hn = rms_norm(x, norm_g)
    proj = hn @ w_in
    sizes = [D_NA, D_NA, D_NA, D_NA, D_WIN, D_KV_WIN, D_KV_WIN, D_WIN, D_MEM, D_MEM]
    points = []
    acc = 0
    for sz in sizes[:-1]:
        acc += sz
        points.append(acc)
    na_q, na_k, na_v, na_g, wq, wk, wv, wg, mq, mg = jnp.split(proj, points, axis=-1)
    qa = rms_norm(na_q.reshape(b, t, N_HEADS_NA, HEAD_DIM), q_norm_g[0]) * scale
    ka = rms_norm(na_k.reshape(b, t, N_HEADS_NA, HEAD_DIM), k_norm_g[0])
    va = na_v.reshape(b, t, N_HEADS_NA, HEAD_DIM)
    ya = neighbourhood_attention(qa, ka, va, rpb) * jax.nn.silu(na_g)
    qb = rms_norm(wq.reshape(b, t, N_HEADS_WIN, HEAD_DIM), q_norm_g[1]) * scale
    kb = rms_norm(wk.reshape(b, t, N_KV_WIN, HEAD_DIM), k_norm_g[1])
    vb = wv.reshape(b, t, N_KV_WIN, HEAD_DIM)
    yb = windowed_gqa(qb, kb, vb, sink) * jax.nn.silu(wg)
    n_mem = mem.shape[1]
    mkv = rms_norm(mem, mem_norm_g) @ w_mem_kv
    mk, mv = jnp.split(mkv, 2, axis=-1)
    km = rms_norm(mk.reshape(b, n_mem, N_HEADS_MEM, HEAD_DIM), k_norm_g[2])
    vm = mv.reshape(b, n_mem, N_HEADS_MEM, HEAD_DIM)
    qc = rms_norm(mq.reshape(b, t, N_HEADS_MEM, HEAD_DIM), q_norm_g[2]) * scale
    yc = memory_attention(qc, km, vm) * jax.nn.silu(mg)
    y = jnp.concatenate([ya, yb, yc], axis=-1) @ w_out
    return x + y


def setup_inputs(seed: int = 0) -> dict:
    key = jax.random.key(seed)
    ks = jax.random.split(key, 13)
    f32 = jnp.float32
    x_prompt = jax.random.normal(ks[0], (BATCH, SEQ, D_MODEL), f32)
    x_sample = jax.random.normal(ks[1], (DEC_BATCH, DEC_SEQ, D_MODEL), f32)
    mem_prompt = jax.random.normal(ks[2], (BATCH, N_MEM, D_MODEL), f32)
    mem_sample = jax.random.normal(ks[3], (DEC_BATCH, N_MEM, D_MODEL), f32)
    norm_g = 1.0 + 0.02 * jax.random.normal(ks[4], (DEPTH, D_MODEL), f32)
    w_in = jax.random.normal(ks[5], (DEPTH, D_MODEL, D_IN), f32) * D_MODEL ** -0.5
    q_norm_g = 1.0 + 0.02 * jax.random.normal(ks[6], (DEPTH, 3, HEAD_DIM), f32)
    k_norm_g = 1.0 + 0.02 * jax.random.normal(ks[7], (DEPTH, 3, HEAD_DIM), f32)
    rpb = 0.1 * jax.random.normal(ks[8], (DEPTH, N_HEADS_NA, 2 * NA_ROWS_MAX - 1, 2 * NA_COLS - 1), f32)
    sink = 0.5 * jax.random.normal(ks[9], (DEPTH, N_HEADS_WIN), f32)
    mem_norm_g = 1.0 + 0.02 * jax.random.normal(ks[10], (DEPTH, D_MODEL), f32)
    w_mem_kv = jax.random.normal(ks[11], (DEPTH, D_MODEL, 2 * D_MEM), f32) * D_MODEL ** -0.5
    w_out = jax.random.normal(ks[12], (DEPTH, D_MIX, D_MODEL), f32) * D_MIX ** -0.5
    return {"x_prompt": x_prompt, "x_sample": x_sample, "mem_prompt": mem_prompt, "mem_sample": mem_sample,
            "norm_g": norm_g, "w_in": w_in, "q_norm_g": q_norm_g, "k_norm_g": k_norm_g, "rpb": rpb,
            "sink": sink, "mem_norm_g": mem_norm_g, "w_mem_kv": w_mem_kv, "w_out": w_out}


def reference(x_prompt, x_sample, mem_prompt, mem_sample, norm_g, w_in, q_norm_g, k_norm_g, rpb, sink,
              mem_norm_g, w_mem_kv, w_out):
    y_prompt = x_prompt
    y_sample = x_sample
    for l in range(DEPTH):
        y_prompt = layer(y_prompt, mem_prompt, norm_g[l], w_in[l], q_norm_g[l], k_norm_g[l], rpb[l], sink[l],
                         mem_norm_g[l], w_mem_kv[l], w_out[l])
        y_sample = layer(y_sample, mem_sample, norm_g[l], w_in[l], q_norm_g[l], k_norm_g[l], rpb[l], sink[l],
                         mem_norm_g[l], w_mem_kv[l], w_out[l])
    return (y_prompt, y_sample)
```

```cpp
#include <hip/hip_runtime.h>
#include <hip/hip_cooperative_groups.h>
#include <cstdio>
#include <cstdint>
namespace cg = cooperative_groups;

#define LAS __attribute__((address_space(3)))
#define DI __device__ __forceinline__
typedef unsigned short bf16_t;
typedef short bf16x8 __attribute__((ext_vector_type(8)));
typedef float f32x2 __attribute__((ext_vector_type(2)));
typedef float f32x4 __attribute__((ext_vector_type(4)));
typedef float f32x16 __attribute__((ext_vector_type(16)));
typedef unsigned u32x2 __attribute__((ext_vector_type(2)));
typedef unsigned u32x4 __attribute__((ext_vector_type(4)));
typedef __bf16 bf16x2_t __attribute__((ext_vector_type(2)));

DI unsigned pk2(float a, float b) { f32x2 v = {a, b}; bf16x2_t r = __builtin_convertvector(v, bf16x2_t); return __builtin_bit_cast(unsigned, r); }
DI float bflo(unsigned u) { return __builtin_bit_cast(float, u << 16); }
DI float bfhi(unsigned u) { return __builtin_bit_cast(float, u & 0xffff0000u); }

constexpr int DM = 1024, NTOK_P = 16384, NTOK = 49152, DEPTH = 4, NMEMTOK = 5120;
constexpr int LDP = 2560;
constexpr int LDVT = NTOK;
constexpr int LDMVT = NMEMTOK;
constexpr float LOG2E = 1.4426950408889634f;
constexpr float RMS_EPS = 1e-6f;
constexpr size_t MiB = 1u << 20;
constexpr size_t WS_ROWSS = 0, WS_MEMSS = 819200, WS_WIN = 1 * MiB, WS_WOUT = 25 * MiB, WS_WMK = 33 * MiB, WS_WMV = 35 * MiB, WS_MEMB = 37 * MiB,
                 WS_MEMK = 47 * MiB, WS_MEMVT = 57 * MiB, WS_XB = 68 * MiB, WS_PROJ = 164 * MiB, WS_VT = 404 * MiB, WS_END = 452 * MiB;
constexpr int LDS_BYTES = 147456;

namespace pg8 {
constexpr int BM = 256, BK = 64, HALF = 128, HTB = HALF * BK * 2, STAGE_BYTES = 8 * HTB, NXCD = 8, WGM = 8;
__host__ __device__ __forceinline__ int lds_byte(int r, int c) { const int st = (r >> 4) * 2 + (c >> 5), rr = r & 15, cc = c & 31, ob = rr * 64 + cc * 2; return st * 1024 + (ob ^ (((ob >> 9) & 1) << 5)); }
__host__ __device__ __forceinline__ void stage_rc(int b, int& R, int& C) { const int st = b / 1024, sb = b % 1024, swz = sb ^ (((sb >> 9) & 1) << 5); R = (st >> 1) * 16 + swz / 64; C = (st & 1) * 32 + (swz % 64) / 2; }
__host__ __device__ __forceinline__ int perm32(int rho) { const int n = rho >> 4, i = rho & 15; return 8 * (i >> 2) + 4 * n + (i & 3); }

struct Unit { int pm, pn; };
struct Gemm { const bf16_t* A; const bf16_t* Bt; int M, N, K, lda, ldb; };

struct StaticOrder {
    int nM, nN, nwg, G, c;
    __device__ void init(int M, int N, int G_, int c_) { nM = M / BM; nN = N / BM; nwg = nM * nN; G = G_; c = c_; }
    __device__ bool next(int i, Unit& u) const {
        const long L = (long)i * G + c; if (L >= nwg) return false;
        int wgid = (int)L; { const int q = nwg / NXCD, r = nwg % NXCD, xcd = wgid % NXCD, off = wgid / NXCD; wgid = (xcd < r ? xcd * (q + 1) : r * (q + 1) + (xcd - r) * q) + off; }
        const int nig = WGM * nN, gid = wgid / nig, fm = gid * WGM, gsz = (nM - fm) < WGM ? (nM - fm) : WGM;
        u.pm = fm + ((wgid % nig) % gsz); u.pn = (wgid % nig) / gsz; return true;
    }
};

template <class Epi, class Sched>
DI void gemm_phase(LAS unsigned char* lds, const Gemm g, const Sched& S, const Epi& E) {
    int tid_ = threadIdx.x; asm volatile("" : "+v"(tid_));
    const int tid = tid_, wid = __builtin_amdgcn_readfirstlane(tid >> 6), lane = tid & 63, wr = wid >> 2, wc = wid & 3, fr = lane & 15, fq = lane >> 4;
    const int K = g.K, nt = K / BK;
    unsigned voffA[2], voffB[2];
#pragma unroll
    for (int i = 0; i < 2; ++i) { int R, C; stage_rc(tid * 16 + i * 8192, R, C); const int Rb = (R & ~31) + perm32(R & 31);
        voffA[i] = (unsigned)(R * g.lda + C) * 2u; voffB[i] = (unsigned)(Rb * g.ldb + C) * 2u; }
    const size_t kstep = (size_t)(BK * 2);
    const size_t hstepA = (size_t)HALF * g.lda * 2, tstepA = 2 * hstepA, hstepB = (size_t)HALF * g.ldb * 2, tstepB = 2 * hstepB;
    const unsigned ldsw = (unsigned)wid * 1024u;
    const int aoff = lds_byte(wr * 64 + fr, fq * 8), boff = lds_byte(wc * 32 + fr, fq * 8);
#define PG8_SA(b, h) (((b) * 2 + (h)) * HTB)
#define PG8_SB(b, h) ((4 + (b) * 2 + (h)) * HTB)
#define PG8_STAGE(bufoff, gbase, voff) do { _Pragma("unroll") for (int _i = 0; _i < 2; ++_i) \
        __builtin_amdgcn_global_load_lds((const unsigned*)((const char*)(gbase) + (voff)[_i]), (LAS unsigned*)(lds + (bufoff) + ldsw + _i * 8192), 16, 0, 0); } while (0)
#define PG8_LDA(dst, b, h) do { _Pragma("unroll") for (int m = 0; m < 4; ++m) _Pragma("unroll") for (int k = 0; k < 2; ++k) dst[m][k] = *(const LAS bf16x8*)(lds + PG8_SA(b, h) + aoff + m * 2048 + k * 1024); } while (0)
#define PG8_LDB(dst, b, h) do { _Pragma("unroll") for (int n = 0; n < 2; ++n) _Pragma("unroll") for (int k = 0; k < 2; ++k) dst[n][k] = *(const LAS bf16x8*)(lds + PG8_SB(b, h) + boff + n * 2048 + k * 1024); } while (0)
#define PG8_MMA(ai, bj, At, Bt) do { __builtin_amdgcn_s_setprio(1); _Pragma("unroll") for (int m = 0; m < 4; ++m) _Pragma("unroll") for (int n = 0; n < 2; ++n) _Pragma("unroll") for (int k = 0; k < 2; ++k) \
        acc[ai][bj][m][n] = __builtin_amdgcn_mfma_f32_16x16x32_bf16(Bt[n][k], At[m][k], acc[ai][bj][m][n], 0, 0, 0); __builtin_amdgcn_s_setprio(0); } while (0)
#define PG8_WAIT_V(n) asm volatile("s_waitcnt vmcnt(" #n ")" ::: "memory")
#define PG8_WAIT_L(n) asm volatile("s_waitcnt lgkmcnt(" #n ")" ::: "memory")
#define PG8_BAR __builtin_amdgcn_s_barrier()
#define PG8_SCHED __builtin_amdgcn_sched_barrier(0)
    Unit cur, nxt; int ui = 0;
    if (!S.next(0, cur)) return;
    f32x4 acc[2][2][4][2];
#pragma unroll
    for (int a = 0; a < 2; ++a)
#pragma unroll
        for (int b = 0; b < 2; ++b)
#pragma unroll
            for (int m = 0; m < 4; ++m)
#pragma unroll
                for (int n = 0; n < 2; ++n) acc[a][b][m][n] = (f32x4){0.f, 0.f, 0.f, 0.f};
    bf16x8 At[4][2], B0[2][2], B1[2][2];
    const char* cA = (const char*)g.A + (size_t)cur.pm * tstepA; const char* cB = (const char*)g.Bt + (size_t)cur.pn * tstepB;
    PG8_STAGE(PG8_SB(0, 0), cB, voffB); PG8_STAGE(PG8_SB(0, 1), cB + hstepB, voffB); PG8_STAGE(PG8_SA(0, 0), cA, voffA); PG8_STAGE(PG8_SA(0, 1), cA + hstepA, voffA);
    if (wr == 1) PG8_BAR;
    PG8_WAIT_V(2); PG8_BAR;
    PG8_STAGE(PG8_SB(1, 0), cB + kstep, voffB); PG8_STAGE(PG8_SA(1, 0), cA + kstep, voffA); PG8_STAGE(PG8_SB(1, 1), cB + hstepB + kstep, voffB);
    PG8_WAIT_V(6); PG8_BAR;
    for (;;) {
        const bool has_next = S.next(ui + 1, nxt);
        const char* nA = has_next ? (const char*)g.A + (size_t)nxt.pm * tstepA : cA; const char* nB = has_next ? (const char*)g.Bt + (size_t)nxt.pn * tstepB : cB;
        for (int t = 0; t < nt; t += 2) {
            const bool last = (t == nt - 2);
            const char* a1 = cA + (size_t)(t + 1) * kstep;
            const char* a2 = last ? nA : cA + (size_t)(t + 2) * kstep; const char* b2 = last ? nB : cB + (size_t)(t + 2) * kstep;
            const char* a3 = a2 + kstep; const char* b3 = b2 + kstep;
            PG8_LDB(B0, 0, 0); PG8_LDB(B1, 0, 1); PG8_SCHED; PG8_LDA(At, 0, 0); PG8_STAGE(PG8_SA(1, 1), a1 + hstepA, voffA);
            PG8_WAIT_V(8); PG8_WAIT_L(0); PG8_BAR; PG8_MMA(0, 0, At, B0); PG8_MMA(0, 1, At, B1); PG8_BAR; PG8_SCHED;
            PG8_LDA(At, 0, 1); PG8_STAGE(PG8_SB(0, 0), b2, voffB); PG8_STAGE(PG8_SB(0, 1), b2 + hstepB, voffB); PG8_STAGE(PG8_SA(0, 0), a2, voffA);
            PG8_WAIT_V(8); PG8_WAIT_L(0); PG8_BAR; PG8_MMA(1, 0, At, B0); PG8_MMA(1, 1, At, B1); PG8_BAR; PG8_SCHED;
            PG8_LDB(B0, 1, 0); PG8_LDB(B1, 1, 1); PG8_SCHED; PG8_LDA(At, 1, 0); PG8_STAGE(PG8_SA(0, 1), a2 + hstepA, voffA);
            PG8_WAIT_V(8); PG8_WAIT_L(0); PG8_BAR; PG8_MMA(0, 0, At, B0); PG8_MMA(0, 1, At, B1); PG8_BAR; PG8_SCHED;
            PG8_LDA(At, 1, 1); PG8_STAGE(PG8_SB(1, 0), b3, voffB); PG8_STAGE(PG8_SB(1, 1), b3 + hstepB, voffB); PG8_STAGE(PG8_SA(1, 0), a3, voffA);
            PG8_WAIT_V(8); PG8_WAIT_L(0); PG8_BAR; PG8_MMA(1, 0, At, B0); PG8_MMA(1, 1, At, B1); PG8_BAR; PG8_SCHED;
        }
        if (wr == 0) PG8_BAR;
        E(acc, cur, wr, wc, fr, fq);
        if (!has_next) break;
#pragma unroll
        for (int a = 0; a < 2; ++a)
#pragma unroll
            for (int b = 0; b < 2; ++b)
#pragma unroll
                for (int m = 0; m < 4; ++m)
#pragma unroll
                    for (int n = 0; n < 2; ++n) acc[a][b][m][n] = (f32x4){0.f, 0.f, 0.f, 0.f};
        cur = nxt; cA = nA; cB = nB; ++ui;
        if (wr == 1) PG8_BAR;
    }
    PG8_WAIT_V(0);
    PG8_BAR;
#undef PG8_SA
#undef PG8_SB
#undef PG8_STAGE
#undef PG8_LDA
#undef PG8_LDB
#undef PG8_MMA
#undef PG8_WAIT_V
#undef PG8_WAIT_L
#undef PG8_BAR
#undef PG8_SCHED
}

struct EpiRow {
    bf16_t* O; int ldc; const float* rowss; const float* qg; const float* kg; int mode;
    DI void operator()(const f32x4 (&acc)[2][2][4][2], const Unit& u, int wr, int wc, int fr, int fq) const {
        const int row0 = u.pm * BM + wr * 64 + fr, col0 = u.pn * BM + 64 * wc + 8 * fq;
        int type; const float* gam = kg; float gsc = 1.f;
        if (mode == 1) { type = 1; gam = kg + u.pn * 192 + 128; }
        else if (u.pn < 4) { type = 0; const int hd = 4 * u.pn + wc; gam = qg + (hd < 6 ? 0 : (hd < 12 ? 64 : 128)); gsc = 0.125f * LOG2E; }
        else if (u.pn < 6) { type = 1; const int hd = 4 * (u.pn - 4) + wc; gam = kg + (hd < 6 ? 0 : 64); }
        else type = 2;
        f32x4 gv[2][2];
#pragma unroll
        for (int bj = 0; bj < 2; ++bj)
#pragma unroll
            for (int n = 0; n < 2; ++n) gv[bj][n] = (type < 2) ? *(const f32x4*)(gam + 32 * bj + 8 * fq + 4 * n) * gsc : (f32x4){1.f, 1.f, 1.f, 1.f};
#pragma unroll
        for (int ai = 0; ai < 2; ++ai)
#pragma unroll
            for (int m = 0; m < 4; ++m) {
                const int row = row0 + ai * HALF + m * 16;
                const float rs = __builtin_amdgcn_rsqf(rowss[row] * (1.0f / 1024.0f) + RMS_EPS);
                f32x4 v[2][2]; float ss = 0.f;
#pragma unroll
                for (int bj = 0; bj < 2; ++bj)
#pragma unroll
                    for (int n = 0; n < 2; ++n) { v[bj][n] = acc[ai][bj][m][n] * rs; const f32x4 x = v[bj][n]; ss += (x[0] * x[0] + x[1] * x[1]) + (x[2] * x[2] + x[3] * x[3]); }
                if (type < 2) {
                    ss += __shfl_xor(ss, 16); ss += __shfl_xor(ss, 32);
                    const float rn = __builtin_amdgcn_rsqf(ss * (1.0f / 64.0f) + RMS_EPS);
#pragma unroll
                    for (int bj = 0; bj < 2; ++bj)
#pragma unroll
                        for (int n = 0; n < 2; ++n) v[bj][n] = v[bj][n] * rn * gv[bj][n];
                } else {
#pragma unroll
                    for (int bj = 0; bj < 2; ++bj)
#pragma unroll
                        for (int n = 0; n < 2; ++n)
#pragma unroll
                            for (int j = 0; j < 4; ++j) { const float x = v[bj][n][j]; v[bj][n][j] = x * __builtin_amdgcn_rcpf(1.0f + __builtin_amdgcn_exp2f(-x * LOG2E)); }
                }
                bf16_t* rowp = O + (size_t)row * ldc + col0;
#pragma unroll
                for (int bj = 0; bj < 2; ++bj) { u32x4 w; w.x = pk2(v[bj][0][0], v[bj][0][1]); w.y = pk2(v[bj][0][2], v[bj][0][3]); w.z = pk2(v[bj][1][0], v[bj][1][1]); w.w = pk2(v[bj][1][2], v[bj][1][3]);
                    *(u32x4*)(rowp + 32 * bj) = w; }
            }
    }
};
struct EpiCol {
    bf16_t* O; int ldc; const float* colss;
    DI void operator()(const f32x4 (&acc)[2][2][4][2], const Unit& u, int wr, int wc, int fr, int fq) const {
        const int row0 = u.pm * BM + wr * 64 + fr, col0 = u.pn * BM + 32 * wc + 8 * fq;
        f32x4 rs[2][2];
#pragma unroll
        for (int bj = 0; bj < 2; ++bj)
#pragma unroll
            for (int n = 0; n < 2; ++n) { const f32x4 s = *(const f32x4*)(colss + col0 + HALF * bj + 4 * n);
#pragma unroll
                for (int j = 0; j < 4; ++j) rs[bj][n][j] = __builtin_amdgcn_rsqf(s[j] * (1.0f / 1024.0f) + RMS_EPS); }
#pragma unroll
        for (int ai = 0; ai < 2; ++ai)
#pragma unroll
            for (int m = 0; m < 4; ++m) { bf16_t* rowp = O + (size_t)(row0 + ai * HALF + m * 16) * ldc + col0;
#pragma unroll
                for (int bj = 0; bj < 2; ++bj) { const f32x4 v0 = acc[ai][bj][m][0] * rs[bj][0], v1 = acc[ai][bj][m][1] * rs[bj][1];
                    u32x4 w; w.x = pk2(v0[0], v0[1]); w.y = pk2(v0[2], v0[3]); w.z = pk2(v1[0], v1[1]); w.w = pk2(v1[2], v1[3]);
                    *(u32x4*)(rowp + HALF * bj) = w; } }
    }
};
struct EpiOut {
    const float* xin_p; const float* xin_s; float* out; bf16_t* xb; float* ss_next; int last;
    DI void operator()(const f32x4 (&acc)[2][2][4][2], const Unit& u, int wr, int wc, int fr, int fq) const {
        const int row0 = u.pm * BM + wr * 64 + fr, col0 = u.pn * BM + 32 * wc + 8 * fq;
        const float* xin = (u.pm < NTOK_P / BM) ? xin_p : xin_s;
#pragma unroll
        for (int ai = 0; ai < 2; ++ai)
#pragma unroll
            for (int m = 0; m < 4; ++m) { const int row = row0 + ai * HALF + m * 16; const size_t off = (size_t)row * DM + col0; float ss = 0.f;
#pragma unroll
                for (int bj = 0; bj < 2; ++bj) { f32x4 v[2];
#pragma unroll
                    for (int n = 0; n < 2; ++n) { const f32x4 x = *(const f32x4*)(xin + off + HALF * bj + 4 * n); v[n] = x + acc[ai][bj][m][n]; *(f32x4*)(out + off + HALF * bj + 4 * n) = v[n];
                        ss += (v[n][0] * v[n][0] + v[n][1] * v[n][1]) + (v[n][2] * v[n][2] + v[n][3] * v[n][3]); }
                    if (!last) { u32x4 w; w.x = pk2(v[0][0], v[0][1]); w.y = pk2(v[0][2], v[0][3]); w.z = pk2(v[1][0], v[1][1]); w.w = pk2(v[1][2], v[1][3]); *(u32x4*)(xb + off + HALF * bj) = w; } }
                if (!last) { ss += __shfl_xor(ss, 16); ss += __shfl_xor(ss, 32); if (fq == 0) atomicAdd(ss_next + row, ss); } }
    }
};
}

namespace att {
#define MFMA32(a, b, c) __builtin_amdgcn_mfma_f32_32x32x16_bf16((a), (b), (c), 0, 0, 0)
struct TaskP {
    bf16_t* qrow_base;
    const bf16_t* grow_base;
    const bf16_t* kbase;
    const bf16_t* vbase;
    int ldk, ldv, nt;
    float minit, linit;
    int rel_row0;
    int qc0;
    int tabh;
    int dq0; float slope;
};
template <int KIND>
DI void attn_task(const TaskP& P, const LAS float* tab, int lane) {
    const int q = lane & 31, hh = lane >> 5;
    const int pil = (q & 0x13) | ((q & 4) << 1) | ((q & 8) >> 1);
    bf16_t* qrow = P.qrow_base + (size_t)q * LDP;
    bf16x8 qf[4];
#pragma unroll
    for (int ks = 0; ks < 4; ++ks) qf[ks] = *(const bf16x8*)(qrow + 32 * hh + 8 * ks);
    f32x16 o0, o1;
#pragma unroll
    for (int i = 0; i < 16; ++i) { o0[i] = 0.f; o1[i] = 0.f; }
    float mrun = P.minit, lrun = (hh == 0) ? P.linit : 0.f;
    const bf16_t* kl = P.kbase + (size_t)pil * P.ldk + 32 * hh;
    const bf16_t* vl = P.vbase + (size_t)pil * P.ldv + 8 * hh;
    const size_t vdb = (size_t)32 * P.ldv;
    bf16x8 kf[4], vf[4];
#pragma unroll
    for (int ks = 0; ks < 4; ++ks) kf[ks] = *(const bf16x8*)(kl + 8 * ks);
    vf[0] = *(const bf16x8*)(vl); vf[1] = *(const bf16x8*)(vl + 16); vf[2] = *(const bf16x8*)(vl + vdb); vf[3] = *(const bf16x8*)(vl + vdb + 16);
    const int qc = P.qc0 + q;
    const int cs = qc - 8 < 0 ? 0 : (qc - 8 > 48 ? 48 : qc - 8);
    for (int t = 0; t < P.nt; ++t) {
        const int tn = (t + 1 < P.nt) ? t + 1 : t;
        bf16x8 kn[4], vn[4];
        { const bf16_t* kp = kl + (size_t)(32 * tn) * P.ldk; const bf16_t* vp = vl + 32 * tn;
#pragma unroll
          for (int ks = 0; ks < 4; ++ks) kn[ks] = *(const bf16x8*)(kp + 8 * ks);
          vn[0] = *(const bf16x8*)(vp); vn[1] = *(const bf16x8*)(vp + 16); vn[2] = *(const bf16x8*)(vp + vdb); vn[3] = *(const bf16x8*)(vp + vdb + 16); }
        f32x16 s;
#pragma unroll
        for (int i = 0; i < 16; ++i) s[i] = 0.f;
#pragma unroll
        for (int ks = 0; ks < 4; ++ks) s = MFMA32(kf[ks], qf[ks], s);
        if (KIND == 0) {
            const int rowb = P.tabh + (P.rel_row0 + (t >> 1)) * 32;
            const int kcb = 32 * (t & 1) + 8 * hh;
            const int db = kcb - qc + 15, mb = kcb - cs;
#pragma unroll
            for (int i = 0; i < 16; ++i) { const int ci = (i & 7) + 16 * (i >> 3);
                int d = db + ci; d = d < 0 ? 0 : (d > 30 ? 30 : d);
                const float bias = tab[rowb + d];
                const bool valid = (unsigned)(mb + ci) < 16u;
                s[i] = valid ? s[i] + bias : -1e30f; }
        } else if (KIND == 1) {
            const int dqb = P.dq0 + q - 8 * hh - 32 * t;
#pragma unroll
            for (int i = 0; i < 16; ++i) { const int ci = (i & 7) + 16 * (i >> 3);
                const float ad = fabsf((float)(dqb - ci));
                s[i] = ad <= 128.f ? s[i] - P.slope * ad : -1e30f; }
        }
        float mx = s[0];
#pragma unroll
        for (int i = 1; i < 16; ++i) mx = fmaxf(mx, s[i]);
        mx = fmaxf(mx, __shfl_xor(mx, 32));
        const float mn = fmaxf(mrun, mx);
        const float alpha = __builtin_amdgcn_exp2f(mrun - mn);
        mrun = mn;
        float ps = 0.f;
#pragma unroll
        for (int i = 0; i < 16; ++i) { s[i] = __builtin_amdgcn_exp2f(s[i] - mn); ps += s[i]; }
        lrun = lrun * alpha + ps;
#pragma unroll
        for (int i = 0; i < 16; ++i) { o0[i] *= alpha; o1[i] *= alpha; }
        bf16x8 pb[2];
#pragma unroll
        for (int sx = 0; sx < 2; ++sx) { u32x4 w; w.x = pk2(s[8 * sx], s[8 * sx + 1]); w.y = pk2(s[8 * sx + 2], s[8 * sx + 3]); w.z = pk2(s[8 * sx + 4], s[8 * sx + 5]); w.w = pk2(s[8 * sx + 6], s[8 * sx + 7]);
            pb[sx] = __builtin_bit_cast(bf16x8, w); }
        o0 = MFMA32(vf[0], pb[0], o0); o0 = MFMA32(vf[1], pb[1], o0);
        o1 = MFMA32(vf[2], pb[0], o1); o1 = MFMA32(vf[3], pb[1], o1);
#pragma unroll
        for (int ks = 0; ks < 4; ++ks) { kf[ks] = kn[ks]; vf[ks] = vn[ks]; }
    }
    const float lt = lrun + __shfl_xor(lrun, 32);
    const float inv = __builtin_amdgcn_rcpf(lt);
    const bf16_t* grow = P.grow_base + (size_t)q * LDP;
#pragma unroll
    for (int db = 0; db < 2; ++db)
#pragma unroll
        for (int g = 0; g < 2; ++g) { const int d0 = 32 * db + 16 * g + 8 * hh;
            const u32x4 gt = *(const u32x4*)(grow + d0);
            float ov[8];
#pragma unroll
            for (int j = 0; j < 8; ++j) ov[j] = (db == 0 ? o0[8 * g + j] : o1[8 * g + j]) * inv;
            u32x4 w; w.x = pk2(ov[0] * bflo(gt.x), ov[1] * bfhi(gt.x)); w.y = pk2(ov[2] * bflo(gt.y), ov[3] * bfhi(gt.y));
            w.z = pk2(ov[4] * bflo(gt.z), ov[5] * bfhi(gt.z)); w.w = pk2(ov[6] * bflo(gt.w), ov[7] * bfhi(gt.w));
            *(u32x4*)(qrow + d0) = w; }
}
}

struct Args {
    const float *x_prompt, *x_sample, *mem_prompt, *mem_sample, *norm_g, *w_in, *q_norm_g, *k_norm_g, *rpb, *sink, *mem_norm_g, *w_mem_kv, *w_out;
    float* out; unsigned char* ws;
};
#define LDS_WAIT() asm volatile("s_waitcnt lgkmcnt(0)" ::: "memory")
DI float wave_sum(float v) {
#pragma unroll
    for (int o = 1; o < 64; o <<= 1) v += __shfl_xor(v, o);
    return v;
}
DI void p0_transpose_item(const float* W, int ldw, int srccol0, bf16_t* WT, int dstrow0, const float* g, LAS float* scr, int kb, int lane) {
    const int k0 = 64 * kb;
#pragma unroll 8
    for (int i = 0; i < 32; ++i) { const int kk = 2 * i + (lane >> 5); const float sc = g ? g[k0 + kk] : 1.f; scr[kk * 33 + (lane & 31)] = W[(size_t)(k0 + kk) * ldw + srccol0 + (lane & 31)] * sc; }
    LDS_WAIT(); asm volatile("" ::: "memory");
    const int c = lane & 7;
#pragma unroll
    for (int j = 0; j < 4; ++j) { const int n = (lane >> 3) + 8 * j; const LAS float* s = scr + (8 * c) * 33 + n;
        u32x4 o; o.x = pk2(s[0 * 33], s[1 * 33]); o.y = pk2(s[2 * 33], s[3 * 33]); o.z = pk2(s[4 * 33], s[5 * 33]); o.w = pk2(s[6 * 33], s[7 * 33]);
        *(u32x4*)(WT + (size_t)(dstrow0 + n) * 1024 + k0 + 8 * c) = o; }
    LDS_WAIT(); asm volatile("" ::: "memory");
}
DI void row_to_bf16(const float* xrow, bf16_t* orow, float* ss_out, int lane) {
    const f32x4* xr = (const f32x4*)xrow + lane;
    f32x4 v[4]; float s = 0.f;
#pragma unroll
    for (int j = 0; j < 4; ++j) { v[j] = xr[64 * j]; s += (v[j].x * v[j].x + v[j].y * v[j].y) + (v[j].z * v[j].z + v[j].w * v[j].w); }
    s = wave_sum(s);
    u32x2* o8 = (u32x2*)orow + lane;
#pragma unroll
    for (int j = 0; j < 4; ++j) { u32x2 w; w.x = pk2(v[j].x, v[j].y); w.y = pk2(v[j].z, v[j].w); o8[64 * j] = w; }
    if (lane == 0) *ss_out = s;
}
DI int segmap(int c) {
    if (c < 384) return c;
    if (c < 768) return 1536 + (c - 384);
    if (c < 1024) return 2560 + (c - 768);
    if (c < 1408) return 384 + (c - 1024);
    if (c < 1536) return 1920 + (c - 1408);
    if (c < 1920) return 1152 + (c - 1536);
    if (c < 2304) return 2176 + (c - 1920);
    return 2816 + (c - 2304);
}

__global__ void __launch_bounds__(512, 2) hymba_fwd(Args a) {
    extern __shared__ __attribute__((aligned(16))) unsigned char lds_raw[];
    LAS unsigned char* lds = (LAS unsigned char*)lds_raw;
    cg::grid_group grid = cg::this_grid();
    const int tid = threadIdx.x, lane = tid & 63, wave = __builtin_amdgcn_readfirstlane(tid >> 6);
    const int G = gridDim.x, bx = blockIdx.x;
    const int gw = bx * 8 + wave, NGW = G * 8;
    unsigned char* ws = a.ws;
    float* ROWSS = (float*)(ws + WS_ROWSS); float* MEMSS = (float*)(ws + WS_MEMSS);
    bf16_t* WIN = (bf16_t*)(ws + WS_WIN); bf16_t* WOUT = (bf16_t*)(ws + WS_WOUT); bf16_t* WMK = (bf16_t*)(ws + WS_WMK); bf16_t* WMV = (bf16_t*)(ws + WS_WMV);
    bf16_t* MEMB = (bf16_t*)(ws + WS_MEMB); bf16_t* MEMK = (bf16_t*)(ws + WS_MEMK); bf16_t* MEMVT = (bf16_t*)(ws + WS_MEMVT);
    bf16_t* XB = (bf16_t*)(ws + WS_XB); bf16_t* PROJ = (bf16_t*)(ws + WS_PROJ); bf16_t* VT = (bf16_t*)(ws + WS_VT);

    {
        LAS float* scr = (LAS float*)(lds + wave * 16384);
        constexpr int I_IN = DEPTH * 96 * 16, I_OUT = DEPTH * 32 * 16, I_MK = DEPTH * 8 * 16, I_MV = I_MK, NITEMS = I_IN + I_OUT + I_MK + I_MV;
        for (int it = gw; it < NITEMS; it += NGW) {
            int r = it;
            if (r < I_IN) { const int l = r / 1536, rem = r % 1536, nb = rem >> 4, kb = rem & 15; int src;
                if (nb < 80) { const int R0 = 32 * nb, pn = R0 >> 8, p = R0 & 255, bj = p >> 7, hd = (p >> 5) & 3; src = segmap(256 * pn + 64 * hd + 32 * bj); }
                else { const int vr = 32 * (nb - 80); src = vr < 384 ? 768 + vr : 2048 + (vr - 384); }
                p0_transpose_item(a.w_in + (size_t)l * 1024 * 3072, 3072, src, WIN + (size_t)l * 3072 * 1024, 32 * nb, a.norm_g + l * 1024, scr, kb, lane); continue; }
            r -= I_IN;
            if (r < I_OUT) { const int l = r / 512, rem = r % 512, nb = rem >> 4, kb = rem & 15;
                p0_transpose_item(a.w_out + (size_t)l * 1024 * 1024, 1024, 32 * nb, WOUT + (size_t)l * 1024 * 1024, 32 * nb, nullptr, scr, kb, lane); continue; }
            r -= I_OUT;
            if (r < I_MK) { const int l = r / 128, rem = r % 128, nb = rem >> 4, kb = rem & 15; const int p = 32 * nb, bj = p >> 7, hd = (p >> 5) & 3;
                p0_transpose_item(a.w_mem_kv + (size_t)l * 1024 * 512, 512, 64 * hd + 32 * bj, WMK + (size_t)l * 256 * 1024, 32 * nb, a.mem_norm_g + l * 1024, scr, kb, lane); continue; }
            r -= I_MK;
            { const int l = r / 128, rem = r % 128, nb = rem >> 4, kb = rem & 15;
                p0_transpose_item(a.w_mem_kv + (size_t)l * 1024 * 512, 512, 256 + 32 * nb, WMV + (size_t)l * 256 * 1024, 32 * nb, a.mem_norm_g + l * 1024, scr, kb, lane); }
        }
        for (int m = gw; m < NTOK + NMEMTOK; m += NGW) {
            if (m < NTOK) { const float* src = m < NTOK_P ? a.x_prompt + (size_t)m * DM : a.x_sample + (size_t)(m - NTOK_P) * DM; row_to_bf16(src, XB + (size_t)m * DM, ROWSS + m, lane); }
            else { const int mm = m - NTOK; const float* src = mm < 1024 ? a.mem_prompt + (size_t)mm * DM : a.mem_sample + (size_t)(mm - 1024) * DM; row_to_bf16(src, MEMB + (size_t)mm * DM, MEMSS + mm, lane); }
        }
        for (int i = bx * 512 + tid; i < 3 * NTOK; i += G * 512) ROWSS[NTOK + i] = 0.f;
    }
    grid.sync();

    {
        pg8::Gemm g{MEMB, WMK, NMEMTOK, 1024, 1024, 1024, 1024}; pg8::StaticOrder S; S.init(NMEMTOK, 1024, G, bx);
        pg8::EpiRow E{MEMK, 1024, MEMSS, a.q_norm_g, a.k_norm_g, 1};
        pg8::gemm_phase<pg8::EpiRow, pg8::StaticOrder>(lds, g, S, E);
    }
    {
        pg8::Gemm g{WMV, MEMB, 1024, NMEMTOK, 1024, 1024, 1024}; pg8::StaticOrder S; S.init(1024, NMEMTOK, G, (bx + 176) % G);
        pg8::EpiCol E{MEMVT, LDMVT, MEMSS};
        pg8::gemm_phase<pg8::EpiCol, pg8::StaticOrder>(lds, g, S, E);
    }

#pragma unroll 1
    for (int l = 0; l < DEPTH; ++l) {
        unsigned char* ws = a.ws; asm volatile("" : "+s"(ws));
        float* ROWSS = (float*)(ws + WS_ROWSS);
        bf16_t* WIN = (bf16_t*)(ws + WS_WIN); bf16_t* WOUT = (bf16_t*)(ws + WS_WOUT);
        bf16_t* MEMK = (bf16_t*)(ws + WS_MEMK); bf16_t* MEMVT = (bf16_t*)(ws + WS_MEMVT);
        bf16_t* XB = (bf16_t*)(ws + WS_XB); bf16_t* PROJ = (bf16_t*)(ws + WS_PROJ); bf16_t* VT = (bf16_t*)(ws + WS_VT);
        {
            pg8::Gemm g{XB, WIN + (size_t)l * 3072 * 1024, NTOK, 2560, 1024, 1024, 1024}; pg8::StaticOrder S; S.init(NTOK, 2560, G, bx);
            pg8::EpiRow E{PROJ, LDP, ROWSS + (size_t)l * NTOK, a.q_norm_g + l * 192, a.k_norm_g + l * 192, 0};
            pg8::gemm_phase<pg8::EpiRow, pg8::StaticOrder>(lds, g, S, E);
        }
        {
            pg8::Gemm g{WIN + (size_t)l * 3072 * 1024 + (size_t)2560 * 1024, XB, 512, NTOK, 1024, 1024, 1024}; pg8::StaticOrder S; S.init(512, NTOK, G, (bx + G / 2) % G);
            pg8::EpiCol E{VT, LDVT, ROWSS + (size_t)l * NTOK};
            pg8::gemm_phase<pg8::EpiCol, pg8::StaticOrder>(lds, g, S, E);
        }
        grid.sync();

        {
            LAS float* tab = (LAS float*)lds;
            int tid2 = threadIdx.x; asm volatile("" : "+v"(tid2));
            const int tid = tid2, lane = tid & 63;
            for (int i = tid; i < 6 * 15 * 32; i += 512) { const int h = i / 480, rem = i % 480, rr = rem >> 5, c = rem & 31;
                tab[i] = c < 31 ? a.rpb[(size_t)((l * 6 + h) * 15 + rr) * 31 + c] * LOG2E : 0.f; }
            __syncthreads();
            for (int task = gw; task < 24576; task += NGW) {
                att::TaskP P;
                if (task < 9216) {
                    const int qh = task & 1, hr = task >> 1, h = hr % 6, rr = hr / 6;
                    int tokbase, r, rows;
                    if (rr < 256) { tokbase = (rr >> 6) * 4096; r = rr & 63; rows = 64; } else { const int r2 = rr - 256; tokbase = NTOK_P + (r2 >> 5) * 2048; r = r2 & 31; rows = 32; }
                    int r0 = r - 4; r0 = r0 < 0 ? 0 : (r0 > rows - 8 ? rows - 8 : r0);
                    const int qtok0 = tokbase + r * 64 + 32 * qh, key0 = tokbase + r0 * 64;
                    P.qrow_base = PROJ + (size_t)qtok0 * LDP + h * 64; P.grow_base = PROJ + (size_t)qtok0 * LDP + 1536 + h * 64;
                    P.kbase = PROJ + (size_t)key0 * LDP + 1024 + h * 64; P.ldk = LDP;
                    P.vbase = VT + (size_t)(h * 64) * LDVT + key0; P.ldv = LDVT; P.nt = 16;
                    P.minit = -1e30f; P.linit = 0.f; P.rel_row0 = r0 - r + 7; P.qc0 = 32 * qh; P.tabh = h * 480; P.dq0 = 0; P.slope = 0.f;
                    att::attn_task<0>(P, tab, lane);
                } else if (task < 18432) {
                    const int idx = task - 9216, h = idx % 6, blk = idx / 6, tok0 = 32 * blk;
                    int tokbase, t0, T;
                    if (tok0 < NTOK_P) { tokbase = tok0 & ~4095; t0 = tok0 & 4095; T = 4096; } else { const int off = tok0 - NTOK_P; tokbase = NTOK_P + (off & ~2047); t0 = off & 2047; T = 2048; }
                    int jlo = 4 - (t0 >> 5); jlo = jlo < 0 ? 0 : jlo;
                    int jhi = ((T - t0) >> 5) + 3; jhi = jhi > 8 ? 8 : jhi;
                    const int sfirst = t0 - 128 + 32 * jlo, kvh = h / 3;
                    P.qrow_base = PROJ + (size_t)(tokbase + t0) * LDP + 384 + h * 64; P.grow_base = PROJ + (size_t)(tokbase + t0) * LDP + 1920 + h * 64;
                    P.kbase = PROJ + (size_t)(tokbase + sfirst) * LDP + 1408 + kvh * 64; P.ldk = LDP;
                    P.vbase = VT + (size_t)(384 + kvh * 64) * LDVT + tokbase + sfirst; P.ldv = LDVT; P.nt = jhi - jlo + 1;
                    P.minit = a.sink[l * 6 + h] * LOG2E; P.linit = 1.f; P.rel_row0 = 0; P.qc0 = 0; P.tabh = 0;
                    P.dq0 = t0 - sfirst; P.slope = __builtin_amdgcn_exp2f(-8.0f * (float)(h + 1) / 6.0f) * LOG2E;
                    att::attn_task<1>(P, tab, lane);
                } else {
                    const int idx = task - 18432, h = idx & 3, blk = idx >> 2, tok0 = 32 * blk;
                    const int bg = tok0 < NTOK_P ? (tok0 >> 12) : 4 + ((tok0 - NTOK_P) >> 11);
                    P.qrow_base = PROJ + (size_t)tok0 * LDP + 768 + h * 64; P.grow_base = PROJ + (size_t)tok0 * LDP + 2304 + h * 64;
                    P.kbase = MEMK + (size_t)(bg * 256) * 1024 + l * 256 + h * 64; P.ldk = 1024;
                    P.vbase = MEMVT + (size_t)(l * 256 + h * 64) * LDMVT + bg * 256; P.ldv = LDMVT; P.nt = 8;
                    P.minit = -1e30f; P.linit = 0.f; P.rel_row0 = 0; P.qc0 = 0; P.tabh = 0; P.dq0 = 0; P.slope = 0.f;
                    att::attn_task<2>(P, tab, lane);
                }
            }
        }
        grid.sync();

        {
            pg8::Gemm g{PROJ, WOUT + (size_t)l * 1024 * 1024, NTOK, 1024, 1024, LDP, 1024}; pg8::StaticOrder S; S.init(NTOK, 1024, G, bx);
            pg8::EpiOut E{l == 0 ? a.x_prompt : a.out, l == 0 ? a.x_sample - (size_t)NTOK_P * DM : a.out, a.out, XB, ROWSS + (size_t)(l + 1 < DEPTH ? l + 1 : 0) * NTOK, l == DEPTH - 1 ? 1 : 0};
            pg8::gemm_phase<pg8::EpiOut, pg8::StaticOrder>(lds, g, S, E);
        }
        if (l + 1 < DEPTH) grid.sync();
    }
}

extern "C" void kernel_launch(void* const* d_in, const int* in_sizes, int n_in, void* d_out, int out_size, void* d_ws, size_t ws_size, hipStream_t stream) {
    static int grid = 0;
    if (grid == 0) {
        if (n_in != 13 || ws_size < WS_END) { fprintf(stderr, "kernel_launch: unexpected n_in %d / ws %zu (need %zu)\n", n_in, ws_size, (size_t)WS_END); grid = -1; return; }
        int dev = 0, cus = 0, per_cu = 0;
        hipGetDevice(&dev);
        hipDeviceGetAttribute(&cus, hipDeviceAttributeMultiprocessorCount, dev);
        if (hipFuncSetAttribute((const void*)hymba_fwd, hipFuncAttributeMaxDynamicSharedMemorySize, LDS_BYTES) != hipSuccess) { fprintf(stderr, "kernel_launch: hipFuncSetAttribute failed\n"); grid = -1; return; }
        if (hipOccupancyMaxActiveBlocksPerMultiprocessor(&per_cu, (const void*)hymba_fwd, 512, LDS_BYTES) != hipSuccess || per_cu < 1) { fprintf(stderr, "kernel_launch: occupancy query failed (%d)\n", per_cu); (void)hipGetLastError(); per_cu = 1; }
        grid = cus * per_cu;
        fprintf(stderr, "kernel_launch: cus %d per_cu %d grid %d\n", cus, per_cu, grid);
    }
    if (grid < 0) return;
    Args a{};
    a.x_prompt = (const float*)d_in[0]; a.x_sample = (const float*)d_in[1]; a.mem_prompt = (const float*)d_in[2]; a.mem_sample = (const float*)d_in[3];
    a.norm_g = (const float*)d_in[4]; a.w_in = (const float*)d_in[5]; a.q_norm_g = (const float*)d_in[6]; a.k_norm_g = (const float*)d_in[7];
    a.rpb = (const float*)d_in[8]; a.sink = (const float*)d_in[9]; a.mem_norm_g = (const float*)d_in[10]; a.w_mem_kv = (const float*)d_in[11]; a.w_out = (const float*)d_in[12];
    a.out = (float*)d_out; a.ws = (unsigned char*)d_ws;
    void* args[] = {&a};
    hipError_t e = hipLaunchCooperativeKernel((const void*)hymba_fwd, dim3(grid), dim3(512), args, LDS_BYTES, stream);
    if (e != hipSuccess) fprintf(stderr, "kernel_launch: cooperative launch failed: %s (grid %d)\n", hipGetErrorString(e), grid);
}
```

```cpp
#include <hip/hip_runtime.h>
#include <hip/hip_cooperative_groups.h>
#include <cstdio>
#include <cstdint>
namespace cg = cooperative_groups;

#define LAS __attribute__((address_space(3)))
#define GAS __attribute__((address_space(1)))
#define DI __device__ __forceinline__
typedef unsigned short bf16_t;
typedef short bf16x8 __attribute__((ext_vector_type(8)));
typedef float f32x2 __attribute__((ext_vector_type(2)));
typedef float f32x4 __attribute__((ext_vector_type(4)));
typedef float f32x16 __attribute__((ext_vector_type(16)));
typedef unsigned u32x2 __attribute__((ext_vector_type(2)));
typedef unsigned u32x4 __attribute__((ext_vector_type(4)));
typedef __bf16 bf16x2_t __attribute__((ext_vector_type(2)));

DI int lane_id() { int x; asm volatile("v_mbcnt_lo_u32_b32 %0, -1, 0\n\tv_mbcnt_hi_u32_b32 %0, -1, %0" : "=&v"(x)); return x; }
DI unsigned pk2(float a, float b) { f32x2 v = {a, b}; bf16x2_t r = __builtin_convertvector(v, bf16x2_t); return __builtin_bit_cast(unsigned, r); }
DI void half_swap(float& a, float& b) { asm volatile("s_nop 1\n\tv_permlane32_swap_b32 %0, %1" : "+v"(a), "+v"(b)); }
DI float half_max(float x) { float a = x, b = x; half_swap(a, b); return fmaxf(a, b); }
DI float half_sum(float x) { float a = x, b = x; half_swap(a, b); return a + b; }
DI float bflo(unsigned u) { return __builtin_bit_cast(float, u << 16); }
DI float bfhi(unsigned u) { return __builtin_bit_cast(float, u & 0xffff0000u); }

constexpr int DM = 1024, NTOK_P = 16384, NTOK = 49152, DEPTH = 4, NMEMTOK = 5120;
constexpr int QLD = 64;
constexpr size_t PGRP = (size_t)NTOK * 64;
constexpr int LDP = 2560;
constexpr int LDVT = NTOK;
constexpr int LDMVT = NMEMTOK;
constexpr float LOG2E = 1.4426950408889634f;
constexpr float RMS_EPS = 1e-6f;
constexpr size_t MiB = 1u << 20;
constexpr size_t WS_ROWSS = 0, WS_MEMSS = 819200, WS_WIN = 1 * MiB, WS_WOUT = 25 * MiB, WS_WMK = 33 * MiB, WS_WMV = 35 * MiB, WS_MEMB = 37 * MiB,
                 WS_MEMK = 47 * MiB, WS_MEMVT = 57 * MiB, WS_XB = 68 * MiB, WS_PROJ = 164 * MiB, WS_VT = 404 * MiB, WS_END = 452 * MiB;
constexpr int LDS_BYTES = 147456;

namespace pg8 {
constexpr int BM = 256, BK = 64, HALF = 128, HTB = HALF * BK * 2, STAGE_BYTES = 8 * HTB, NXCD = 8, WGM = 8;
__host__ __device__ __forceinline__ int lds_byte(int r, int c) { const int st = (r >> 4) * 2 + (c >> 5), rr = r & 15, cc = c & 31, ob = rr * 64 + cc * 2; return st * 1024 + (ob ^ (((ob >> 9) & 1) << 5)); }
__host__ __device__ __forceinline__ void stage_rc(int b, int& R, int& C) { const int st = b / 1024, sb = b % 1024, swz = sb ^ (((sb >> 9) & 1) << 5); R = (st >> 1) * 16 + swz / 64; C = (st & 1) * 32 + (swz % 64) / 2; }
__host__ __device__ __forceinline__ int perm32(int rho) { const int n = rho >> 4, i = rho & 15; return 8 * (i >> 2) + 4 * n + (i & 3); }

struct Unit { int pm, pn; };
struct Gemm { const bf16_t* A; const bf16_t* Bt; int M, N, K, lda, ldb; size_t ksA, ksB; };

struct StaticOrder {
    int nM, nN, nwg, G, c;
    __device__ void init(int M, int N, int G_, int c_) { nM = M / BM; nN = N / BM; nwg = nM * nN; G = G_; c = c_; }
    __device__ bool next(int i, Unit& u) const {
        const long L = (long)i * G + c; if (L >= nwg) return false;
        int wgid = (int)L; { const int q = nwg / NXCD, r = nwg % NXCD, xcd = wgid % NXCD, off = wgid / NXCD; wgid = (xcd < r ? xcd * (q + 1) : r * (q + 1) + (xcd - r) * q) + off; }
        const int nig = WGM * nN, gid = wgid / nig, fm = gid * WGM, gsz = (nM - fm) < WGM ? (nM - fm) : WGM;
        u.pm = fm + ((wgid % nig) % gsz); u.pn = (wgid % nig) / gsz; return true;
    }
};

template <class Epi, class Sched>
DI void gemm_phase(LAS unsigned char* lds, const Gemm g, const Sched& S, const Epi& E, int wave_) {
    int tid_ = wave_ * 64 + lane_id(); asm volatile("" : "+v"(tid_));
    const int tid = tid_, wid = __builtin_amdgcn_readfirstlane(tid >> 6), lane = tid & 63, wr = wid >> 2, wc = wid & 3, fr = lane & 15, fq = lane >> 4;
    const int K = g.K, nt = K / BK;
    unsigned voffA[2], voffB[2];
#pragma unroll
    for (int i = 0; i < 2; ++i) { int R, C; stage_rc(tid * 16 + i * 8192, R, C); const int Rb = (R & ~31) + perm32(R & 31);
        voffA[i] = (unsigned)(R * g.lda + C) * 2u; voffB[i] = (unsigned)(Rb * g.ldb + C) * 2u; }
    const size_t kstepA = g.ksA, kstepB = g.ksB;
    const size_t hstepA = (size_t)HALF * g.lda * 2, tstepA = 2 * hstepA, hstepB = (size_t)HALF * g.ldb * 2, tstepB = 2 * hstepB;
    const unsigned ldsw = (unsigned)wid * 1024u;
    const int aoff = lds_byte(wr * 64 + fr, fq * 8), boff = lds_byte(wc * 32 + fr, fq * 8);
#define PG8_SA(b, h) (((b) * 2 + (h)) * HTB)
#define PG8_SB(b, h) ((4 + (b) * 2 + (h)) * HTB)
#define PG8_STAGE(bufoff, gbase, voff) do { _Pragma("unroll") for (int _i = 0; _i < 2; ++_i) \
        __builtin_amdgcn_global_load_lds((const unsigned*)((const char*)(gbase) + (voff)[_i]), (LAS unsigned*)(lds + (bufoff) + ldsw + _i * 8192), 16, 0, 0); } while (0)
#define PG8_LDA(dst, b, h) do { _Pragma("unroll") for (int m = 0; m < 4; ++m) _Pragma("unroll") for (int k = 0; k < 2; ++k) dst[m][k] = *(const LAS bf16x8*)(lds + PG8_SA(b, h) + aoff + m * 2048 + k * 1024); } while (0)
#define PG8_LDB(dst, b, h) do { _Pragma("unroll") for (int n = 0; n < 2; ++n) _Pragma("unroll") for (int k = 0; k < 2; ++k) dst[n][k] = *(const LAS bf16x8*)(lds + PG8_SB(b, h) + boff + n * 2048 + k * 1024); } while (0)
#define PG8_MMA(ai, bj, At, Bt) do { __builtin_amdgcn_s_setprio(1); _Pragma("unroll") for (int m = 0; m < 4; ++m) _Pragma("unroll") for (int n = 0; n < 2; ++n) _Pragma("unroll") for (int k = 0; k < 2; ++k) \
        acc[ai][bj][m][n] = __builtin_amdgcn_mfma_f32_16x16x32_bf16(Bt[n][k], At[m][k], acc[ai][bj][m][n], 0, 0, 0); __builtin_amdgcn_s_setprio(0); } while (0)
#define PG8_WAIT_V(n) asm volatile("s_waitcnt vmcnt(" #n ")" ::: "memory")
#define PG8_WAIT_L(n) asm volatile("s_waitcnt lgkmcnt(" #n ")" ::: "memory")
#define PG8_BAR __builtin_amdgcn_s_barrier()
#define PG8_SCHED __builtin_amdgcn_sched_barrier(0)
    Unit cur, nxt; int ui = 0;
    if (!S.next(0, cur)) return;
    f32x4 acc[2][2][4][2];
#pragma unroll
    for (int a = 0; a < 2; ++a)
#pragma unroll
        for (int b = 0; b < 2; ++b)
#pragma unroll
            for (int m = 0; m < 4; ++m)
#pragma unroll
                for (int n = 0; n < 2; ++n) acc[a][b][m][n] = (f32x4){0.f, 0.f, 0.f, 0.f};
    bf16x8 At[4][2], B0[2][2], B1[2][2];
    const char* cA = (const char*)g.A + (size_t)cur.pm * tstepA; const char* cB = (const char*)g.Bt + (size_t)cur.pn * tstepB;
    PG8_STAGE(PG8_SB(0, 0), cB, voffB); PG8_STAGE(PG8_SB(0, 1), cB + hstepB, voffB); PG8_STAGE(PG8_SA(0, 0), cA, voffA); PG8_STAGE(PG8_SA(0, 1), cA + hstepA, voffA);
    if (wr == 1) PG8_BAR;
    PG8_WAIT_V(2); PG8_BAR;
    PG8_STAGE(PG8_SB(1, 0), cB + kstepB, voffB); PG8_STAGE(PG8_SA(1, 0), cA + kstepA, voffA); PG8_STAGE(PG8_SB(1, 1), cB + hstepB + kstepB, voffB);
    PG8_WAIT_V(6); PG8_BAR;
    for (;;) {
        const bool has_next = S.next(ui + 1, nxt);
        const char* nA = has_next ? (const char*)g.A + (size_t)nxt.pm * tstepA : cA; const char* nB = has_next ? (const char*)g.Bt + (size_t)nxt.pn * tstepB : cB;
        for (int t = 0; t < nt; t += 2) {
            const bool last = (t == nt - 2);
            const char* a1 = cA + (size_t)(t + 1) * kstepA;
            const char* a2 = last ? nA : cA + (size_t)(t + 2) * kstepA; const char* b2 = last ? nB : cB + (size_t)(t + 2) * kstepB;
            const char* a3 = a2 + kstepA; const char* b3 = b2 + kstepB;
            PG8_LDB(B0, 0, 0); PG8_LDB(B1, 0, 1); PG8_SCHED; PG8_LDA(At, 0, 0); PG8_STAGE(PG8_SA(1, 1), a1 + hstepA, voffA);
            PG8_WAIT_V(8); PG8_WAIT_L(0); PG8_BAR; PG8_MMA(0, 0, At, B0); PG8_MMA(0, 1, At, B1); PG8_BAR; PG8_SCHED;
            PG8_LDA(At, 0, 1); PG8_STAGE(PG8_SB(0, 0), b2, voffB); PG8_STAGE(PG8_SB(0, 1), b2 + hstepB, voffB); PG8_STAGE(PG8_SA(0, 0), a2, voffA);
            PG8_WAIT_V(8); PG8_WAIT_L(0); PG8_BAR; PG8_MMA(1, 0, At, B0); PG8_MMA(1, 1, At, B1); PG8_BAR; PG8_SCHED;
            PG8_LDB(B0, 1, 0); PG8_LDB(B1, 1, 1); PG8_SCHED; PG8_LDA(At, 1, 0); PG8_STAGE(PG8_SA(0, 1), a2 + hstepA, voffA);
            PG8_WAIT_V(8); PG8_WAIT_L(0); PG8_BAR; PG8_MMA(0, 0, At, B0); PG8_MMA(0, 1, At, B1); PG8_BAR; PG8_SCHED;
            PG8_LDA(At, 1, 1); PG8_STAGE(PG8_SB(1, 0), b3, voffB); PG8_STAGE(PG8_SB(1, 1), b3 + hstepB, voffB); PG8_STAGE(PG8_SA(1, 0), a3, voffA);
            PG8_WAIT_V(8); PG8_WAIT_L(0); PG8_BAR; PG8_MMA(1, 0, At, B0); PG8_MMA(1, 1, At, B1); PG8_BAR; PG8_SCHED;
        }
        if (wr == 0) PG8_BAR;
        E(acc, cur, wr, wc, fr, fq);
        if (!has_next) break;
#pragma unroll
        for (int a = 0; a < 2; ++a)
#pragma unroll
            for (int b = 0; b < 2; ++b)
#pragma unroll
                for (int m = 0; m < 4; ++m)
#pragma unroll
                    for (int n = 0; n < 2; ++n) acc[a][b][m][n] = (f32x4){0.f, 0.f, 0.f, 0.f};
        cur = nxt; cA = nA; cB = nB; ++ui;
        if (wr == 1) PG8_BAR;
    }
    PG8_WAIT_V(0);
    PG8_BAR;
#undef PG8_SA
#undef PG8_SB
#undef PG8_STAGE
#undef PG8_LDA
#undef PG8_LDB
#undef PG8_MMA
#undef PG8_WAIT_V
#undef PG8_WAIT_L
#undef PG8_BAR
#undef PG8_SCHED
}

struct EpiRow {
    bf16_t* O; int ldc; const float* rowss; const float* qg; const float* kg; int mode; int blocked;
    DI void operator()(const f32x4 (&acc)[2][2][4][2], const Unit& u, int wr, int wc, int fr, int fq) const {
        const int row0 = u.pm * BM + wr * 64 + fr, col0 = u.pn * BM + 64 * wc + 8 * fq;
        int type; const float* gam = kg; float gsc = 1.f;
        if (mode == 1) { type = 1; gam = kg + u.pn * 192 + 128; }
        else if (u.pn < 4) { type = 0; const int hd = 4 * u.pn + wc; gam = qg + (hd < 6 ? 0 : (hd < 12 ? 64 : 128)); gsc = 0.125f * LOG2E; }
        else if (u.pn < 6) { type = 1; const int hd = 4 * (u.pn - 4) + wc; gam = kg + (hd < 6 ? 0 : 64); }
        else type = 2;
        f32x4 gv[2][2];
#pragma unroll
        for (int bj = 0; bj < 2; ++bj)
#pragma unroll
            for (int n = 0; n < 2; ++n) gv[bj][n] = (type < 2) ? *(const f32x4*)(gam + 32 * bj + 8 * fq + 4 * n) * gsc : (f32x4){1.f, 1.f, 1.f, 1.f};
        float rsv[2][4];
#pragma unroll
        for (int ai = 0; ai < 2; ++ai)
#pragma unroll
            for (int m = 0; m < 4; ++m) rsv[ai][m] = ((const GAS float*)rowss)[row0 + ai * HALF + m * 16];
#pragma unroll
        for (int ai = 0; ai < 2; ++ai)
#pragma unroll
            for (int m = 0; m < 4; ++m) {
                const int row = row0 + ai * HALF + m * 16;
                const float rs = __builtin_amdgcn_rsqf(rsv[ai][m] * (1.0f / 1024.0f) + RMS_EPS);
                f32x4 v[2][2]; float ss = 0.f;
#pragma unroll
                for (int bj = 0; bj < 2; ++bj)
#pragma unroll
                    for (int n = 0; n < 2; ++n) { v[bj][n] = acc[ai][bj][m][n] * rs; const f32x4 x = v[bj][n]; ss += (x[0] * x[0] + x[1] * x[1]) + (x[2] * x[2] + x[3] * x[3]); }
                if (type < 2) {
                    ss += __shfl_xor(ss, 16); ss = half_sum(ss);
                    const float rn = __builtin_amdgcn_rsqf(ss * (1.0f / 64.0f) + RMS_EPS);
#pragma unroll
                    for (int bj = 0; bj < 2; ++bj)
#pragma unroll
                        for (int n = 0; n < 2; ++n) v[bj][n] = v[bj][n] * rn * gv[bj][n];
                } else {
#pragma unroll
                    for (int bj = 0; bj < 2; ++bj)
#pragma unroll
                        for (int n = 0; n < 2; ++n)
#pragma unroll
                            for (int j = 0; j < 4; ++j) { const float x = v[bj][n][j]; v[bj][n][j] = x * __builtin_amdgcn_rcpf(1.0f + __builtin_amdgcn_exp2f(-x * LOG2E)); }
                }
                GAS bf16_t* rowp = blocked ? (GAS bf16_t*)O + ((size_t)(4 * u.pn + wc) * NTOK + row) * 64 + 8 * fq : (GAS bf16_t*)O + (size_t)row * ldc + col0;
#pragma unroll
                for (int bj = 0; bj < 2; ++bj) { u32x4 w; w.x = pk2(v[bj][0][0], v[bj][0][1]); w.y = pk2(v[bj][0][2], v[bj][0][3]); w.z = pk2(v[bj][1][0], v[bj][1][1]); w.w = pk2(v[bj][1][2], v[bj][1][3]);
                    *(GAS u32x4*)(rowp + 32 * bj) = w; }
            }
    }
};
struct EpiCol {
    bf16_t* O; int ldc; const float* colss; int blocked;
    DI void operator()(const f32x4 (&acc)[2][2][4][2], const Unit& u, int wr, int wc, int fr, int fq) const {
        const int row0 = u.pm * BM + wr * 64 + fr, col0 = u.pn * BM + 32 * wc + 8 * fq;
        f32x4 rs[2][2];
#pragma unroll
        for (int bj = 0; bj < 2; ++bj)
#pragma unroll
            for (int n = 0; n < 2; ++n) { const f32x4 s = *(const GAS f32x4*)((const GAS float*)colss + col0 + HALF * bj + 4 * n);
#pragma unroll
                for (int j = 0; j < 4; ++j) rs[bj][n][j] = __builtin_amdgcn_rsqf(s[j] * (1.0f / 1024.0f) + RMS_EPS); }
#pragma unroll
        for (int ai = 0; ai < 2; ++ai)
#pragma unroll
            for (int m = 0; m < 4; ++m) { const int row = row0 + ai * HALF + m * 16;
                GAS bf16_t* rowp = blocked ? (GAS bf16_t*)O + ((size_t)(col0 >> 6) * 512 + row) * 64 + (col0 & 63) : (GAS bf16_t*)O + (size_t)row * ldc + col0;
                const size_t bjstep = blocked ? (size_t)2 * 32768 : (size_t)HALF;
#pragma unroll
                for (int bj = 0; bj < 2; ++bj) { const f32x4 v0 = acc[ai][bj][m][0] * rs[bj][0], v1 = acc[ai][bj][m][1] * rs[bj][1];
                    u32x4 w; w.x = pk2(v0[0], v0[1]); w.y = pk2(v0[2], v0[3]); w.z = pk2(v1[0], v1[1]); w.w = pk2(v1[2], v1[3]);
                    *(GAS u32x4*)(rowp + bjstep * bj) = w; } }
    }
};
struct EpiOut {
    const float* xin_p; const float* xin_s; float* out; bf16_t* xb; float* ss_next; int last;
    DI void operator()(const f32x4 (&acc)[2][2][4][2], const Unit& u, int wr, int wc, int fr, int fq) const {
        const int row0 = u.pm * BM + wr * 64 + fr, col0 = u.pn * BM + 32 * wc + 8 * fq;
        const GAS float* xin = (const GAS float*)((u.pm < NTOK_P / BM) ? xin_p : xin_s);
        GAS float* outg = (GAS float*)out; GAS bf16_t* xbg = (GAS bf16_t*)xb;
#pragma unroll
        for (int ai = 0; ai < 2; ++ai) {
            f32x4 xv[4][2][2];
#pragma unroll
            for (int m = 0; m < 4; ++m) { const size_t off = (size_t)(row0 + ai * HALF + m * 16) * DM + col0;
#pragma unroll
                for (int bj = 0; bj < 2; ++bj)
#pragma unroll
                    for (int n = 0; n < 2; ++n) xv[m][bj][n] = *(const GAS f32x4*)(xin + off + HALF * bj + 4 * n); }
#pragma unroll
            for (int m = 0; m < 4; ++m) { const int row = row0 + ai * HALF + m * 16; const size_t off = (size_t)row * DM + col0; float ss = 0.f;
#pragma unroll
                for (int bj = 0; bj < 2; ++bj) { f32x4 v[2];
#pragma unroll
                    for (int n = 0; n < 2; ++n) { v[n] = xv[m][bj][n] + acc[ai][bj][m][n]; __builtin_nontemporal_store(v[n], (GAS f32x4*)(outg + off + HALF * bj + 4 * n));
                        ss += (v[n][0] * v[n][0] + v[n][1] * v[n][1]) + (v[n][2] * v[n][2] + v[n][3] * v[n][3]); }
                    if (!last) { u32x4 w; w.x = pk2(v[0][0], v[0][1]); w.y = pk2(v[0][2], v[0][3]); w.z = pk2(v[1][0], v[1][1]); w.w = pk2(v[1][2], v[1][3]); *(GAS u32x4*)(xbg + off + HALF * bj) = w; } }
                if (!last) { ss += __shfl_xor(ss, 16); ss = half_sum(ss); if (fq == 0) atomicAdd(ss_next + row, ss); } }
        }
    }
};
}

namespace att {
#define MFMA32(a, b, c) __builtin_amdgcn_mfma_f32_32x32x16_bf16((a), (b), (c), 0, 0, 0)
constexpr int TAB_OFF = 131072;
struct TaskP {
    bf16_t* qrow_base;
    const bf16_t* grow_base;
    const bf16_t* kbase;
    const bf16_t* vbase;
    int ldk, ldv, nt;
    float minit, linit;
    int rel_row0, tabh;
    int vk32;
    int dq0, jofs; float slope;
};
template <int KIND>
DI void attn_task(const TaskP& P, const LAS float* tab, LAS unsigned char* wl, int lane) {
    const int q = lane & 31, hh = lane >> 5;
    const int pil = (q & 0x13) | ((q & 4) << 1) | ((q & 8) >> 1);
    GAS bf16_t* qrow = (GAS bf16_t*)P.qrow_base + q * QLD;
    bf16x8 qf[2][4];
#pragma unroll
    for (int u = 0; u < 2; ++u)
#pragma unroll
        for (int ks = 0; ks < 4; ++ks) qf[u][ks] = *(const GAS bf16x8*)(qrow + (32 * u) * QLD + 32 * hh + 8 * ks);
    f32x16 oa[2], ob[2];
#pragma unroll
    for (int u = 0; u < 2; ++u)
#pragma unroll
        for (int i = 0; i < 16; ++i) { oa[u][i] = 0.f; ob[u][i] = 0.f; }
    float mrun[2], lrun[2];
    mrun[0] = mrun[1] = P.minit; lrun[0] = lrun[1] = (hh == 0) ? P.linit : 0.f;
    const int l3 = lane >> 3, l4 = lane >> 4;
    const int vc = (lane & 3) ^ (l4 & 3);
    const GAS bf16_t* kg = (const GAS bf16_t*)P.kbase;
    const GAS bf16_t* vg0 = (const GAS bf16_t*)P.vbase;
    const unsigned kro0 = (unsigned)(pil * 128 + (((4 * hh) ^ ((pil >> 1) & 7)) * 16));
    const unsigned vro0 = (unsigned)(4096 + pil * 64 + ((hh ^ ((pil >> 2) & 3)) * 16));
    const int kca = (lane & 7) ^ (l4 & 7);
    const unsigned kof0 = (unsigned)(l3 * P.ldk + 8 * kca) * 2u;
    const unsigned vof0 = (unsigned)((lane >> 2) * P.ldv + ((KIND == 0) ? ((vc >> 1) * 32768 + 8 * (vc & 1)) : (8 * vc))) * 2u;
#define ATT_RP(t_) ((((t_) >> 2) - (P.tabh >> 12)) & 3)
#define ATT_TILEKEY(t_) ((KIND == 0) ? (128 * ATT_RP(t_) + 16 * ((t_) & 3)) : (32 * (t_)))
#define ATT_KROW(i_) ((KIND == 0) ? (((i_) >> 1) * 64 + 8 * ((i_) & 1)) : (8 * (i_)))
#define ATT_PIECE_K(t_, buf_, i_) do { const GAS char* kt_ = (const GAS char*)(kg + (size_t)(ATT_TILEKEY(t_) + ATT_KROW(i_)) * P.ldk); \
        __builtin_amdgcn_global_load_lds((const GAS unsigned*)(kt_ + (((i_) & 1) ? (kof0 ^ 64u) : kof0)), (LAS unsigned*)(wl + (buf_) * 8192 + (i_) * 1024), 16, 0, 0); } while (0)
#define ATT_TILEKEY_V(t_) ((KIND == 0) ? (65536 * ATT_RP(t_) + 16 * ((t_) & 3)) : (KIND == 1) ? ((((P.vk32 + (t_)) >> 1) * 32768) + ((P.vk32 + (t_)) & 1) * 32) : (32 * (t_)))
#define ATT_PIECE_V(t_, buf_, i_) do { const GAS char* vt_ = (const GAS char*)(vg0 + (size_t)(16 * (i_)) * P.ldv + ATT_TILEKEY_V(t_)); \
        __builtin_amdgcn_global_load_lds((const GAS unsigned*)(vt_ + vof0), (LAS unsigned*)(wl + (buf_) * 8192 + 4096 + (i_) * 1024), 16, 0, 0); } while (0)
#pragma unroll
    for (int i = 0; i < 4; ++i) ATT_PIECE_K(0, 0, i);
#pragma unroll
    for (int i = 0; i < 4; ++i) ATT_PIECE_V(0, 0, i);
    if (P.nt > 1) {
#pragma unroll
        for (int i = 0; i < 4; ++i) ATT_PIECE_K(1, 1, i);
    }
    for (int t = 0; t < P.nt; ++t) {
        asm volatile("" ::: "memory");
        if (t + 1 < P.nt) asm volatile("s_waitcnt vmcnt(8)" ::: "memory"); else asm volatile("s_waitcnt vmcnt(4)" ::: "memory");
        const LAS unsigned char* bb = wl + (t & 1) * 8192;
        const bool moreK = (t + 2 < P.nt), moreV = (t + 1 < P.nt);
        bool act[2];
#pragma unroll
        for (int u = 0; u < 2; ++u) { act[u] = true;
            if (KIND == 0) { const int cb = t & 3; act[u] = !(cb < u || cb > u + 2); }
            if (KIND == 1) { const int j = P.jofs + t; act[u] = !(j < u || j > u + 8); } }
        f32x16 sv[2];
        {
            bf16x8 kf[4];
#pragma unroll
            for (int ks = 0; ks < 4; ++ks) kf[ks] = *(const LAS bf16x8*)(bb + (kro0 ^ (16u * ks)));
#pragma unroll
            for (int u = 0; u < 2; ++u) {
#pragma unroll
                for (int i = 0; i < 16; ++i) sv[u][i] = 0.f;
                if (act[u]) {
                    __builtin_amdgcn_s_setprio(1);
#pragma unroll
                    for (int ks = 0; ks < 4; ++ks) sv[u] = MFMA32(kf[ks], qf[u][ks], sv[u]);
                    __builtin_amdgcn_s_setprio(0);
                }
            }
        }
        asm volatile("s_waitcnt lgkmcnt(0)" ::: "memory");
        bf16x8 pb[2][2];
#pragma unroll
        for (int u = 0; u < 2; ++u) {
            f32x16 s = sv[u];
            float mn = 0.f;
            if (act[u]) {
                if (KIND == 0) {
                    const int rp = ATT_RP(t), cb = t & 3;
                    const int qc = 32 * u + q;
                    const int cs = qc - 8 < 0 ? 0 : (qc - 8 > 48 ? 48 : qc - 8);
                    const int kcb = 16 * cb + 8 * hh;
                    const int db = kcb - qc + 15, mb = kcb - cs;
                    const LAS float* tr0 = tab + ((P.tabh & 4095) + (P.rel_row0 + 2 * rp) * 32 + db);
                    const unsigned taddr = (unsigned)(size_t)tr0;
#pragma unroll
                    for (int hb = 0; hb < 2; ++hb) {
                        float bz[8]; const unsigned ta2 = taddr + 128u * hb;
                        asm volatile("ds_read_b32 %0, %8\n\tds_read_b32 %1, %8 offset:4\n\tds_read_b32 %2, %8 offset:8\n\tds_read_b32 %3, %8 offset:12\n\t"
                                     "ds_read_b32 %4, %8 offset:16\n\tds_read_b32 %5, %8 offset:20\n\tds_read_b32 %6, %8 offset:24\n\tds_read_b32 %7, %8 offset:28\n\t"
                                     "s_waitcnt lgkmcnt(0)"
                                     : "=&v"(bz[0]), "=&v"(bz[1]), "=&v"(bz[2]), "=&v"(bz[3]), "=&v"(bz[4]), "=&v"(bz[5]), "=&v"(bz[6]), "=&v"(bz[7])
                                     : "v"(ta2) : "memory");
#pragma unroll
                        for (int ci = 0; ci < 8; ++ci) { const bool valid = (unsigned)(mb + ci) < 16u;
                            s[8 * hb + ci] = valid ? s[8 * hb + ci] + bz[ci] : -INFINITY; }
                    }
                } else if (KIND == 1) {
                    const float fdq = (float)(P.dq0 + 32 * u + q - 8 * hh - 32 * t);
                    const int jrel = P.jofs + t - u;
                    if (jrel >= 1 && jrel <= 7) {
#pragma unroll
                        for (int i = 0; i < 16; ++i) { const float ci = (float)((i & 7) + 16 * (i >> 3)); s[i] = s[i] - P.slope * fabsf(fdq - ci); }
                    } else {
#pragma unroll
                        for (int i = 0; i < 16; ++i) { const float ci = (float)((i & 7) + 16 * (i >> 3));
                            const float ad = fabsf(fdq - ci);
                            s[i] = ad <= 128.f ? s[i] - P.slope * ad : -INFINITY; }
                    }
                }
                float mx = fmaxf(s[0], s[1]);
#pragma unroll
                for (int i = 2; i < 16; ++i) mx = fmaxf(mx, s[i]);
                mx = half_max(mx);
                const float mold = mrun[u];
                mn = (mx > mold + 8.f) ? mx : mold;
                if (__builtin_amdgcn_ballot_w64(mn != mold)) {
                    const float alpha = __builtin_amdgcn_exp2f(mold - mn);
                    lrun[u] *= alpha;
#pragma unroll
                    for (int i = 0; i < 16; ++i) { oa[u][i] *= alpha; ob[u][i] *= alpha; }
                    mrun[u] = mn;
                }
            }
            __builtin_amdgcn_sched_barrier(0);
            if (moreK) { __builtin_amdgcn_s_setprio(2); ATT_PIECE_K(t + 2, t & 1, 2 * u); ATT_PIECE_K(t + 2, t & 1, 2 * u + 1); __builtin_amdgcn_s_setprio(0); }
            __builtin_amdgcn_sched_barrier(0);
            if (act[u]) {
                float ps0 = 0.f, ps1 = 0.f;
#pragma unroll
                for (int i = 0; i < 16; i += 2) { s[i] = __builtin_amdgcn_exp2f(s[i] - mn); s[i + 1] = __builtin_amdgcn_exp2f(s[i + 1] - mn); ps0 += s[i]; ps1 += s[i + 1]; }
                lrun[u] += ps0 + ps1;
#pragma unroll
                for (int sx = 0; sx < 2; ++sx) { u32x4 w; w.x = pk2(s[8 * sx], s[8 * sx + 1]); w.y = pk2(s[8 * sx + 2], s[8 * sx + 3]); w.z = pk2(s[8 * sx + 4], s[8 * sx + 5]); w.w = pk2(s[8 * sx + 6], s[8 * sx + 7]);
                    pb[u][sx] = __builtin_bit_cast(bf16x8, w); }
            }
            __builtin_amdgcn_sched_barrier(0);
            if (moreV) { __builtin_amdgcn_s_setprio(2); ATT_PIECE_V(t + 1, (t + 1) & 1, 2 * u); ATT_PIECE_V(t + 1, (t + 1) & 1, 2 * u + 1); __builtin_amdgcn_s_setprio(0); }
            __builtin_amdgcn_sched_barrier(0);
        }
        if (moreK) asm volatile("s_waitcnt vmcnt(8)" ::: "memory");
        else if (moreV) asm volatile("s_waitcnt vmcnt(4)" ::: "memory");
        else asm volatile("s_waitcnt vmcnt(0)" ::: "memory");
        {
            bf16x8 vf[4];
            vf[0] = *(const LAS bf16x8*)(bb + vro0); vf[1] = *(const LAS bf16x8*)(bb + (vro0 ^ 32u));
            vf[2] = *(const LAS bf16x8*)(bb + vro0 + 2048); vf[3] = *(const LAS bf16x8*)(bb + (vro0 ^ 32u) + 2048);
#pragma unroll
            for (int u = 0; u < 2; ++u) {
                if (!act[u]) continue;
                __builtin_amdgcn_s_setprio(1);
                oa[u] = MFMA32(vf[0], pb[u][0], oa[u]); oa[u] = MFMA32(vf[1], pb[u][1], oa[u]);
                ob[u] = MFMA32(vf[2], pb[u][0], ob[u]); ob[u] = MFMA32(vf[3], pb[u][1], ob[u]);
                __builtin_amdgcn_s_setprio(0);
            }
        }
        asm volatile("s_waitcnt lgkmcnt(0)" ::: "memory");
    }
#undef ATT_PIECE_K
#undef ATT_TILEKEY
#undef ATT_RP
#undef ATT_TILEKEY_V
#undef ATT_KROW
#undef ATT_PIECE_V
#pragma unroll
    for (int u = 0; u < 2; ++u) {
        const float lt = half_sum(lrun[u]);
        const float inv = __builtin_amdgcn_rcpf(lt);
        const GAS bf16_t* grow = (const GAS bf16_t*)P.grow_base + (32 * u + q) * QLD;
        GAS bf16_t* orow = qrow + (32 * u) * QLD;
#pragma unroll
        for (int db = 0; db < 2; ++db)
#pragma unroll
            for (int g = 0; g < 2; ++g) { const int d0 = 32 * db + 16 * g + 8 * hh;
                const u32x4 gt = *(const GAS u32x4*)(grow + d0);
                float ov[8];
#pragma unroll
                for (int j = 0; j < 8; ++j) ov[j] = (db == 0 ? oa[u][8 * g + j] : ob[u][8 * g + j]) * inv;
                u32x4 w; w.x = pk2(ov[0] * bflo(gt.x), ov[1] * bfhi(gt.x)); w.y = pk2(ov[2] * bflo(gt.y), ov[3] * bfhi(gt.y));
                w.z = pk2(ov[4] * bflo(gt.z), ov[5] * bfhi(gt.z)); w.w = pk2(ov[6] * bflo(gt.w), ov[7] * bfhi(gt.w));
                *(GAS u32x4*)(orow + d0) = w; }
    }
}
}


#define XB_TMO      128
#define XB_XCNT(j)  (256  + 64 * (j))
#define XB_XSUB(j)  (1280 + 64 * (j))
#define XB_XGEN(j)  (2304 + 64 * (j))
#define XB_TOP      3328
#define XB_TOPGEN   3392
#define XCD_BAR_WORDS 3456
#define XB_SPIN_CAP (1u << 22)
DI unsigned xb_ld(unsigned* p)              { return __hip_atomic_load(p, __ATOMIC_RELAXED, __HIP_MEMORY_SCOPE_AGENT); }
DI unsigned xb_add(unsigned* p, unsigned v) { return __hip_atomic_fetch_add(p, v, __ATOMIC_RELAXED, __HIP_MEMORY_SCOPE_AGENT); }
DI unsigned xb_xcc_id() { return (unsigned)__builtin_amdgcn_s_getreg((3 << 11) | 20) & 0xFu; }
#define XB_SPIN(cond, bar) do { unsigned _sp = 0; while (cond) { __builtin_amdgcn_s_sleep(1); \
    if ((++_sp & 255u) == 0u) { if (xb_ld(&(bar)[XB_TMO])) break; if (_sp > XB_SPIN_CAP) { atomicAdd(&(bar)[XB_TMO], 1u); break; } } } } while (0)
struct XcdBarrier { unsigned* bar; unsigned x; volatile LAS unsigned* st; };
DI XcdBarrier xcd_barrier_post(unsigned* bar, volatile LAS unsigned* st, bool t0) {
    XcdBarrier b; b.bar = bar; b.x = xb_xcc_id(); b.st = st;
    if (t0) (void)xb_add(&bar[XB_XCNT(b.x)], 1u);
    return b;
}
DI void xcd_barrier_complete(unsigned* bar, unsigned x, unsigned& nloc, unsigned& nx) {
    const unsigned G = gridDim.x * gridDim.y * gridDim.z;
    unsigned sum, cnt, mine, sp = 0u;
    for (;;) {
        sum = 0u; cnt = 0u; mine = 0u;
#pragma unroll
        for (unsigned j = 0; j < 16; ++j) { const unsigned c = xb_ld(&bar[XB_XCNT(j)]); sum += c; cnt += (c > 0u) ? 1u : 0u; mine = (j == x) ? c : mine; }
        if (sum == G) break;
        __builtin_amdgcn_s_sleep(1);
        if ((++sp & 255u) == 0u) { if (xb_ld(&bar[XB_TMO])) break; if (sp > XB_SPIN_CAP) { atomicAdd(&bar[XB_TMO], 1u); break; } }
    }
    nloc = mine > 0u ? mine : 1u; nx = cnt > 0u ? cnt : 1u;
}
DI void xcd_barrier(const XcdBarrier& b, int wave_) {
    const bool t0 = (wave_ == 0) && (lane_id() == 0);
    asm volatile("s_waitcnt vmcnt(0)" ::: "memory");
    __syncthreads();
    if (t0) {
        unsigned* bar = b.bar;
        __builtin_amdgcn_s_waitcnt(0);
        unsigned nloc = b.st[0], nx = b.st[1];
        if (nloc == 0u) { xcd_barrier_complete(bar, b.x, nloc, nx); b.st[0] = nloc; b.st[1] = nx; }
        const unsigned old = xb_add(&bar[XB_XSUB(b.x)], 1u);
        const unsigned gen = old / nloc;
        if (old + 1u == (gen + 1u) * nloc) {
            __builtin_amdgcn_fence(__ATOMIC_RELEASE, "agent");
            asm volatile("s_waitcnt vmcnt(0)" ::: "memory");
            const unsigned og = xb_add(&bar[XB_TOP], 1u);
            const unsigned tg = og / nx;
            if (og + 1u == (tg + 1u) * nx) xb_add(&bar[XB_TOPGEN], 1u);
            else XB_SPIN(xb_ld(&bar[XB_TOPGEN]) == tg, bar);
            __builtin_amdgcn_fence(__ATOMIC_ACQUIRE, "agent");
            xb_add(&bar[XB_XGEN(b.x)], 1u);
            asm volatile("s_waitcnt vmcnt(0)" ::: "memory");
        } else {
            XB_SPIN(xb_ld(&bar[XB_XGEN(b.x)]) == gen, bar);
            __builtin_amdgcn_fence(__ATOMIC_ACQUIRE, "agent");
            asm volatile("s_waitcnt vmcnt(0)" ::: "memory");
        }
    }
    __syncthreads();
}
constexpr size_t WS_BAR = 901120;
constexpr size_t WS_CTR = WS_BAR + 13824;
constexpr int LDS_BARST = 143360;

struct Args {
    const float *x_prompt, *x_sample, *mem_prompt, *mem_sample, *norm_g, *w_in, *q_norm_g, *k_norm_g, *rpb, *sink, *mem_norm_g, *w_mem_kv, *w_out;
    float* out; unsigned char* ws;
};
#define LDS_WAIT() asm volatile("s_waitcnt lgkmcnt(0)" ::: "memory")
DI float wave_sum(float v) {
#pragma unroll
    for (int o = 1; o < 64; o <<= 1) v += __shfl_xor(v, o);
    return v;
}
DI void p0_transpose_item(const float* W, int ldw, int srccol0, bf16_t* WT, int dstrow0, const float* g, LAS float* scr, int kb, int lane) {
    const int k0 = 64 * kb;
    float wv[32];
    const GAS float* Wg = (const GAS float*)W + (size_t)(k0 + (lane >> 5)) * ldw + srccol0 + (lane & 31);
#pragma unroll
    for (int i = 0; i < 32; ++i) wv[i] = Wg[(size_t)(2 * i) * ldw];
    const float g0 = g ? ((const GAS float*)g)[k0 + (lane & 63)] : 1.f;
#pragma unroll
    for (int i = 0; i < 32; ++i) { const int kk = 2 * i + (lane >> 5); const float sc = __shfl(g0, kk); scr[kk * 33 + (lane & 31)] = wv[i] * sc; }
    LDS_WAIT(); asm volatile("" ::: "memory");
    const int c = lane & 7;
#pragma unroll
    for (int j = 0; j < 4; ++j) { const int n = (lane >> 3) + 8 * j; const LAS float* s = scr + (8 * c) * 33 + n;
        u32x4 o; o.x = pk2(s[0 * 33], s[1 * 33]); o.y = pk2(s[2 * 33], s[3 * 33]); o.z = pk2(s[4 * 33], s[5 * 33]); o.w = pk2(s[6 * 33], s[7 * 33]);
        *(u32x4*)(WT + (size_t)(dstrow0 + n) * 1024 + k0 + 8 * c) = o; }
    LDS_WAIT(); asm volatile("" ::: "memory");
}
DI void rows4_to_bf16(const float* src, bf16_t* dst, float* ssq, int m0, int st, int lane) {
    f32x4 v[4][4]; float sq[4];
#pragma unroll
    for (int r = 0; r < 4; ++r) { const GAS f32x4* xr = (const GAS f32x4*)(src + (size_t)(m0 + r * st) * DM) + lane;
#pragma unroll
        for (int j = 0; j < 4; ++j) v[r][j] = xr[64 * j]; }
#pragma unroll
    for (int r = 0; r < 4; ++r) { sq[r] = 0.f;
#pragma unroll
        for (int j = 0; j < 4; ++j) sq[r] += (v[r][j].x * v[r][j].x + v[r][j].y * v[r][j].y) + (v[r][j].z * v[r][j].z + v[r][j].w * v[r][j].w);
        sq[r] = wave_sum(sq[r]);
        GAS u32x2* o8 = (GAS u32x2*)(dst + (size_t)(m0 + r * st) * DM) + lane;
#pragma unroll
        for (int j = 0; j < 4; ++j) { u32x2 w; w.x = pk2(v[r][j].x, v[r][j].y); w.y = pk2(v[r][j].z, v[r][j].w); o8[64 * j] = w; }
        if (lane == 0) ((GAS float*)ssq)[m0 + r * st] = sq[r]; }
}
DI int segmap(int c) {
    if (c < 384) return c;
    if (c < 768) return 1536 + (c - 384);
    if (c < 1024) return 2560 + (c - 768);
    if (c < 1408) return 384 + (c - 1024);
    if (c < 1536) return 1920 + (c - 1408);
    if (c < 1920) return 1152 + (c - 1536);
    if (c < 2304) return 2176 + (c - 1920);
    return 2816 + (c - 2304);
}

__global__ void __launch_bounds__(512, 2) hymba_fwd(Args a) {
    extern __shared__ __attribute__((aligned(16))) unsigned char lds_raw[];
    LAS unsigned char* lds = (LAS unsigned char*)lds_raw;
    cg::grid_group grid = cg::this_grid();
    const int wave = __builtin_amdgcn_readfirstlane((int)threadIdx.x >> 6);
    const int lane = lane_id(), tid = wave * 64 + lane;
    const int G = gridDim.x, bx = blockIdx.x;
    const int gw = bx * 8 + wave, NGW = G * 8;
    unsigned char* ws = a.ws;
    float* ROWSS = (float*)(ws + WS_ROWSS); float* MEMSS = (float*)(ws + WS_MEMSS);
    bf16_t* WIN = (bf16_t*)(ws + WS_WIN); bf16_t* WOUT = (bf16_t*)(ws + WS_WOUT); bf16_t* WMK = (bf16_t*)(ws + WS_WMK); bf16_t* WMV = (bf16_t*)(ws + WS_WMV);
    bf16_t* MEMB = (bf16_t*)(ws + WS_MEMB); bf16_t* MEMK = (bf16_t*)(ws + WS_MEMK); bf16_t* MEMVT = (bf16_t*)(ws + WS_MEMVT);
    bf16_t* XB = (bf16_t*)(ws + WS_XB); bf16_t* PROJ = (bf16_t*)(ws + WS_PROJ); bf16_t* VT = (bf16_t*)(ws + WS_VT);

#ifdef PROBE_SEL
    unsigned long long tq[4] = {0, 0, 0, 0}; unsigned long long tlast = __builtin_amdgcn_s_memrealtime();
#define STAMP(k) do { const unsigned long long tnow = __builtin_amdgcn_s_memrealtime(); tq[k] += tnow - tlast; tlast = tnow; } while (0)
#else
#define STAMP(k) do {} while (0)
#endif
    if (tid == 0) { ((volatile LAS unsigned*)(lds + LDS_BARST))[0] = 0u; ((volatile LAS unsigned*)(lds + LDS_BARST))[1] = 0u; }
    __syncthreads();
    const XcdBarrier xbar = xcd_barrier_post((unsigned*)(a.ws + WS_BAR), (volatile LAS unsigned*)(lds + LDS_BARST), tid == 0);
    {
        LAS float* scr = (LAS float*)(lds + wave * 16384);
        constexpr int I_IN = DEPTH * 96 * 16, I_OUT = DEPTH * 32 * 16, I_MK = DEPTH * 8 * 16, I_MV = I_MK, NITEMS = I_IN + I_OUT + I_MK + I_MV;
        for (int it = gw; it < NITEMS; it += NGW) {
            int r = it;
            if (r < I_IN) { const int l = r / 1536, rem = r % 1536, nb = rem >> 4, kb = rem & 15; int src;
                if (nb < 80) { const int R0 = 32 * nb, pn = R0 >> 8, p = R0 & 255, bj = p >> 7, hd = (p >> 5) & 3; src = segmap(256 * pn + 64 * hd + 32 * bj); }
                else { const int vr = 32 * (nb - 80); src = vr < 384 ? 768 + vr : 2048 + (vr - 384); }
                p0_transpose_item(a.w_in + (size_t)l * 1024 * 3072, 3072, src, WIN + (size_t)l * 3072 * 1024, 32 * nb, a.norm_g + l * 1024, scr, kb, lane); continue; }
            r -= I_IN;
            if (r < I_OUT) { const int l = r / 512, rem = r % 512, nb = rem >> 4, kb = rem & 15;
                p0_transpose_item(a.w_out + (size_t)l * 1024 * 1024, 1024, 32 * nb, WOUT + (size_t)l * 1024 * 1024, 32 * nb, nullptr, scr, kb, lane); continue; }
            r -= I_OUT;
            if (r < I_MK) { const int l = r / 128, rem = r % 128, nb = rem >> 4, kb = rem & 15; const int p = 32 * nb, bj = p >> 7, hd = (p >> 5) & 3;
                p0_transpose_item(a.w_mem_kv + (size_t)l * 1024 * 512, 512, 64 * hd + 32 * bj, WMK + (size_t)l * 256 * 1024, 32 * nb, a.mem_norm_g + l * 1024, scr, kb, lane); continue; }
            r -= I_MK;
            { const int l = r / 128, rem = r % 128, nb = rem >> 4, kb = rem & 15;
                p0_transpose_item(a.w_mem_kv + (size_t)l * 1024 * 512, 512, 256 + 32 * nb, WMV + (size_t)l * 256 * 1024, 32 * nb, a.mem_norm_g + l * 1024, scr, kb, lane); }
        }
        for (int m = gw; m < NTOK_P / 4; m += NGW) rows4_to_bf16(a.x_prompt, XB, ROWSS, m, NTOK_P / 4, lane);
        for (int m = gw; m < (NTOK - NTOK_P) / 4; m += NGW) rows4_to_bf16(a.x_sample, XB + (size_t)NTOK_P * DM, ROWSS + NTOK_P, m, (NTOK - NTOK_P) / 4, lane);
        for (int m = gw; m < 1024 / 4; m += NGW) rows4_to_bf16(a.mem_prompt, MEMB, MEMSS, m, 1024 / 4, lane);
        for (int m = gw; m < 4096 / 4; m += NGW) rows4_to_bf16(a.mem_sample, MEMB + (size_t)1024 * DM, MEMSS + 1024, m, 4096 / 4, lane);
        for (int i = bx * 512 + tid; i < 3 * NTOK; i += G * 512) ROWSS[NTOK + i] = 0.f;
    }
    if (a.ws == nullptr) grid.sync();
    xcd_barrier(xbar, wave);
    STAMP(0);

    {
        pg8::Gemm g{MEMB, WMK, NMEMTOK, 1024, 1024, 1024, 1024, 128, 128}; pg8::StaticOrder S; S.init(NMEMTOK, 1024, G, bx);
        pg8::EpiRow E{MEMK, 1024, MEMSS, a.q_norm_g, a.k_norm_g, 1, 0};
        pg8::gemm_phase<pg8::EpiRow, pg8::StaticOrder>(lds, g, S, E, wave);
    }
    {
        pg8::Gemm g{WMV, MEMB, 1024, NMEMTOK, 1024, 1024, 1024, 128, 128}; pg8::StaticOrder S; S.init(1024, NMEMTOK, G, (bx + 176) % G);
        pg8::EpiCol E{MEMVT, LDMVT, MEMSS, 0};
        pg8::gemm_phase<pg8::EpiCol, pg8::StaticOrder>(lds, g, S, E, wave);
    }

#pragma unroll 1
    for (int l = 0; l < DEPTH; ++l) {
        unsigned char* ws = a.ws; asm volatile("" : "+s"(ws));
        float* ROWSS = (float*)(ws + WS_ROWSS);
        bf16_t* WIN = (bf16_t*)(ws + WS_WIN); bf16_t* WOUT = (bf16_t*)(ws + WS_WOUT);
        bf16_t* MEMK = (bf16_t*)(ws + WS_MEMK); bf16_t* MEMVT = (bf16_t*)(ws + WS_MEMVT);
        bf16_t* XB = (bf16_t*)(ws + WS_XB); bf16_t* PROJ = (bf16_t*)(ws + WS_PROJ); bf16_t* VT = (bf16_t*)(ws + WS_VT);
        {
            pg8::Gemm g{XB, WIN + (size_t)l * 3072 * 1024, NTOK, 2560, 1024, 1024, 1024, 128, 128}; pg8::StaticOrder S; S.init(NTOK, 2560, G, bx);
            pg8::EpiRow E{PROJ, LDP, ROWSS + (size_t)l * NTOK, a.q_norm_g + l * 192, a.k_norm_g + l * 192, 0, 1};
            pg8::gemm_phase<pg8::EpiRow, pg8::StaticOrder>(lds, g, S, E, wave);
        }
        {
            pg8::Gemm g{WIN + (size_t)l * 3072 * 1024 + (size_t)2560 * 1024, XB, 512, NTOK, 1024, 1024, 1024, 128, 128}; pg8::StaticOrder S; S.init(512, NTOK, G, (bx + G / 2) % G);
            pg8::EpiCol E{VT, LDVT, ROWSS + (size_t)l * NTOK, 1};
            pg8::gemm_phase<pg8::EpiCol, pg8::StaticOrder>(lds, g, S, E, wave);
        }
        xcd_barrier(xbar, wave);
        STAMP(1);

        {
            int tid2 = wave * 64 + lane_id(); asm volatile("" : "+v"(tid2));
            const int tid = tid2, lane = tid & 63;
            LAS float* tab = (LAS float*)(lds + att::TAB_OFF);
            for (int i = tid; i < 6 * 15 * 32; i += 512) { const int h = i / 480, rem = i % 480, rr = rem >> 5, c = rem & 31;
                tab[i] = c < 31 ? a.rpb[(size_t)((l * 6 + h) * 15 + rr) * 31 + c] * LOG2E : 0.f; }
            __syncthreads();
            LAS unsigned char* wl = lds + wave * 16384;
            const bool xcd_ok = (G == 256);
            const int xcd = xcd_ok ? (bx & 7) : 0, jw = xcd_ok ? ((bx >> 3) * 8 + wave) : gw, jstride = xcd_ok ? 256 : NGW;
            const int nA = xcd_ok ? 576 : 4608, nB = nA, nC = xcd_ok ? 384 : 3072;
            unsigned* qctr = (unsigned*)(a.ws + WS_CTR) + (l * 8 + xcd) * 64;
            for (int li = jw; li < nA + nB + nC; ) {
                unsigned nv = 0u;
                if (xcd_ok && lane == 0) nv = __hip_atomic_fetch_add(qctr, 1u, __ATOMIC_RELAXED, __HIP_MEMORY_SCOPE_AGENT);
                att::TaskP P;
                if (li < nA) {
                    const int task = xcd * nA + li;
                    const int h = task % 6, rr = task / 6;
                    int tokbase, r, rows;
                    if (rr < 256) { tokbase = (rr >> 6) * 4096; r = rr & 63; rows = 64; } else { const int r2 = rr - 256; tokbase = NTOK_P + (r2 >> 5) * 2048; r = r2 & 31; rows = 32; }
                    int r0 = r - 4; r0 = r0 < 0 ? 0 : (r0 > rows - 8 ? rows - 8 : r0);
                    const int qtok0 = tokbase + r * 64, key0 = tokbase + r0 * 64;
                    P.qrow_base = PROJ + ((size_t)h * NTOK + qtok0) * 64; P.grow_base = PROJ + ((size_t)(24 + h) * NTOK + qtok0) * 64;
                    P.kbase = PROJ + ((size_t)(16 + h) * NTOK + key0) * 64; P.ldk = 64;
                    P.vbase = VT + (size_t)(key0 >> 6) * 32768 + (h * 64) * 64; P.ldv = 64; P.vk32 = 0; P.nt = 16;
                    P.minit = -1e30f; P.linit = 0.f; P.rel_row0 = r0 - r + 7; P.tabh = h * 480 + (((r0 >> 1) & 3) << 12); P.dq0 = 0; P.jofs = 0; P.slope = 0.f;
                    att::attn_task<0>(P, tab, wl, lane);
                } else if (li < nA + nB) {
                    const int idx = xcd * nB + (li - nA), h = idx % 6, blk = idx / 6, tok0 = 64 * blk;
                    int tokbase, t0, T;
                    if (tok0 < NTOK_P) { tokbase = tok0 & ~4095; t0 = tok0 & 4095; T = 4096; } else { const int off = tok0 - NTOK_P; tokbase = NTOK_P + (off & ~2047); t0 = off & 2047; T = 2048; }
                    int jlo = 4 - (t0 >> 5); jlo = jlo < 0 ? 0 : jlo;
                    int jhi = ((T - t0) >> 5) + 3; jhi = jhi > 9 ? 9 : jhi;
                    const int sfirst = t0 - 128 + 32 * jlo, kvh = h / 3;
                    P.qrow_base = PROJ + ((size_t)(6 + h) * NTOK + tokbase + t0) * 64; P.grow_base = PROJ + ((size_t)(30 + h) * NTOK + tokbase + t0) * 64;
                    P.kbase = PROJ + ((size_t)(22 + kvh) * NTOK + tokbase + sfirst) * 64; P.ldk = 64;
                    P.vbase = VT + (384 + kvh * 64) * 64; P.ldv = 64; P.vk32 = (tokbase + sfirst) >> 5; P.nt = jhi - jlo + 1;
                    P.minit = a.sink[l * 6 + h] * LOG2E; P.linit = 1.f; P.rel_row0 = 0; P.tabh = 0;
                    P.dq0 = t0 - sfirst; P.jofs = jlo; P.slope = __builtin_amdgcn_exp2f(-8.0f * (float)(h + 1) / 6.0f) * LOG2E;
                    att::attn_task<1>(P, tab, wl, lane);
                } else {
                    const int idx = xcd * nC + (li - nA - nB), h = idx & 3, blk = idx >> 2, tok0 = 64 * blk;
                    const int bg = tok0 < NTOK_P ? (tok0 >> 12) : 4 + ((tok0 - NTOK_P) >> 11);
                    P.qrow_base = PROJ + ((size_t)(12 + h) * NTOK + tok0) * 64; P.grow_base = PROJ + ((size_t)(36 + h) * NTOK + tok0) * 64;
                    P.kbase = MEMK + (size_t)(bg * 256) * 1024 + l * 256 + h * 64; P.ldk = 1024;
                    P.vbase = MEMVT + (size_t)(l * 256 + h * 64) * LDMVT + bg * 256; P.ldv = LDMVT; P.vk32 = 0; P.nt = 8;
                    P.minit = -1e30f; P.linit = 0.f; P.rel_row0 = 0; P.tabh = 0; P.dq0 = 0; P.jofs = 0; P.slope = 0.f;
                    att::attn_task<2>(P, tab, wl, lane);
                }
                li = xcd_ok ? (int)(256u + (unsigned)__builtin_amdgcn_readfirstlane((int)nv)) : li + jstride;
            }
        }
        xcd_barrier(xbar, wave);
        STAMP(2);

        {
            pg8::Gemm g{PROJ, WOUT + (size_t)l * 1024 * 1024, NTOK, 1024, 1024, 64, 1024, PGRP * 2, 128}; pg8::StaticOrder S; S.init(NTOK, 1024, G, bx);
            pg8::EpiOut E{l == 0 ? a.x_prompt : a.out, l == 0 ? a.x_sample - (size_t)NTOK_P * DM : a.out, a.out, XB, ROWSS + (size_t)(l + 1 < DEPTH ? l + 1 : 0) * NTOK, l == DEPTH - 1 ? 1 : 0};
            pg8::gemm_phase<pg8::EpiOut, pg8::StaticOrder>(lds, g, S, E, wave);
        }
#ifdef PROBE_SEL
        grid.sync();
        STAMP(3);
#else
        if (l + 1 < DEPTH) xcd_barrier(xbar, wave);
#endif
    }
#ifdef PROBE_SEL
    if (bx == 0 && wave == 0 && lane_id() == 0) a.out[(size_t)NTOK_P * DM] += (float)tq[PROBE_SEL] * (0.01f / 50.0f);
#endif
}

extern "C" void kernel_launch(void* const* d_in, const int* in_sizes, int n_in, void* d_out, int out_size, void* d_ws, size_t ws_size, hipStream_t stream) {
    static int grid = 0;
    if (grid == 0) {
        if (n_in != 13 || ws_size < WS_END) { fprintf(stderr, "kernel_launch: unexpected n_in %d / ws %zu (need %zu)\n", n_in, ws_size, (size_t)WS_END); grid = -1; return; }
        int dev = 0, cus = 0, per_cu = 0;
        hipGetDevice(&dev);
        hipDeviceGetAttribute(&cus, hipDeviceAttributeMultiprocessorCount, dev);
        if (hipFuncSetAttribute((const void*)hymba_fwd, hipFuncAttributeMaxDynamicSharedMemorySize, LDS_BYTES) != hipSuccess) { fprintf(stderr, "kernel_launch: hipFuncSetAttribute failed\n"); grid = -1; return; }
        if (hipOccupancyMaxActiveBlocksPerMultiprocessor(&per_cu, (const void*)hymba_fwd, 512, LDS_BYTES) != hipSuccess || per_cu < 1) { fprintf(stderr, "kernel_launch: occupancy query failed (%d)\n", per_cu); (void)hipGetLastError(); per_cu = 1; }
        grid = cus * per_cu;
        fprintf(stderr, "kernel_launch: cus %d per_cu %d grid %d\n", cus, per_cu, grid);
    }
    if (grid < 0) return;
    Args a{};
    a.x_prompt = (const float*)d_in[0]; a.x_sample = (const float*)d_in[1]; a.mem_prompt = (const float*)d_in[2]; a.mem_sample = (const float*)d_in[3];
    a.norm_g = (const float*)d_in[4]; a.w_in = (const float*)d_in[5]; a.q_norm_g = (const float*)d_in[6]; a.k_norm_g = (const float*)d_in[7];
    a.rpb = (const float*)d_in[8]; a.sink = (const float*)d_in[9]; a.mem_norm_g = (const float*)d_in[10]; a.w_mem_kv = (const float*)d_in[11]; a.w_out = (const float*)d_in[12];
    a.out = (float*)d_out; a.ws = (unsigned char*)d_ws;
    if (hipMemsetAsync((char*)d_ws + WS_BAR, 0, XCD_BAR_WORDS * 4 + 32 * 256, stream) != hipSuccess) { fprintf(stderr, "kernel_launch: memset of the barrier words failed\n"); return; }
    void* args[] = {&a};
    hipError_t e = hipLaunchCooperativeKernel((const void*)hymba_fwd, dim3(grid), dim3(512), args, LDS_BYTES, stream);
    if (e != hipSuccess) fprintf(stderr, "kernel_launch: cooperative launch failed: %s (grid %d)\n", hipGetErrorString(e), grid);
}
```

```cpp
#include <hip/hip_runtime.h>
#include <hip/hip_cooperative_groups.h>
#include <cstdio>
#include <cstdint>
namespace cg = cooperative_groups;

#define LAS __attribute__((address_space(3)))
#define GAS __attribute__((address_space(1)))
#define DI __device__ __forceinline__
typedef unsigned short bf16_t;
typedef short bf16x8 __attribute__((ext_vector_type(8)));
typedef float f32x2 __attribute__((ext_vector_type(2)));
typedef float f32x4 __attribute__((ext_vector_type(4)));
typedef float f32x16 __attribute__((ext_vector_type(16)));
typedef unsigned u32x2 __attribute__((ext_vector_type(2)));
typedef unsigned u32x4 __attribute__((ext_vector_type(4)));
typedef __bf16 bf16x2_t __attribute__((ext_vector_type(2)));

DI int lane_id() { int x; asm volatile("v_mbcnt_lo_u32_b32 %0, -1, 0\n\tv_mbcnt_hi_u32_b32 %0, -1, %0" : "=&v"(x)); return x; }
DI unsigned pk2(float a, float b) { f32x2 v = {a, b}; bf16x2_t r = __builtin_convertvector(v, bf16x2_t); return __builtin_bit_cast(unsigned, r); }
DI void half_swap(float& a, float& b) { asm volatile("s_nop 1\n\tv_permlane32_swap_b32 %0, %1" : "+v"(a), "+v"(b)); }
DI float half_max(float x) { float a = x, b = x; half_swap(a, b); return fmaxf(a, b); }
DI float half_sum(float x) { float a = x, b = x; half_swap(a, b); return a + b; }
DI float bflo(unsigned u) { return __builtin_bit_cast(float, u << 16); }
DI float bfhi(unsigned u) { return __builtin_bit_cast(float, u & 0xffff0000u); }

constexpr int DM = 1024, NTOK_P = 16384, NTOK = 49152, DEPTH = 4, NMEMTOK = 5120;
constexpr int QLD = 64;
constexpr size_t PGRP = (size_t)NTOK * 64;
constexpr int LDP = 2560;
constexpr int LDVT = NTOK;
constexpr int LDMVT = NMEMTOK;
constexpr float LOG2E = 1.4426950408889634f;
constexpr float RMS_EPS = 1e-6f;
constexpr size_t MiB = 1u << 20;
constexpr size_t WS_ROWSS = 0, WS_MEMSS = 819200, WS_WIN = 1 * MiB, WS_WOUT = 25 * MiB, WS_WMK = 33 * MiB, WS_WMV = 35 * MiB, WS_MEMB = 37 * MiB,
                 WS_MEMK = 47 * MiB, WS_MEMVT = 57 * MiB, WS_XB = 68 * MiB, WS_PROJ = 164 * MiB, WS_VT = 404 * MiB, WS_END = 452 * MiB;
constexpr int LDS_BYTES = 147456;

namespace pg8 {
constexpr int BM = 256, BK = 64, HALF = 128, HTB = HALF * BK * 2, STAGE_BYTES = 8 * HTB, NXCD = 8, WGM = 8;
__host__ __device__ __forceinline__ int lds_byte(int r, int c) { const int st = (r >> 4) * 2 + (c >> 5), rr = r & 15, cc = c & 31, ob = rr * 64 + cc * 2; return st * 1024 + (ob ^ (((ob >> 9) & 1) << 5)); }
__host__ __device__ __forceinline__ void stage_rc(int b, int& R, int& C) { const int st = b / 1024, sb = b % 1024, swz = sb ^ (((sb >> 9) & 1) << 5); R = (st >> 1) * 16 + swz / 64; C = (st & 1) * 32 + (swz % 64) / 2; }
__host__ __device__ __forceinline__ int perm32(int rho) { const int n = rho >> 4, i = rho & 15; return 8 * (i >> 2) + 4 * n + (i & 3); }

struct Unit { int pm, pn; };
struct Gemm { const bf16_t* A; const bf16_t* Bt; int M, N, K, lda, ldb; size_t ksA, ksB; };

struct StaticOrder {
    int nM, nN, nwg, G, c;
    __device__ void init(int M, int N, int G_, int c_) { nM = M / BM; nN = N / BM; nwg = nM * nN; G = G_; c = c_; }
    __device__ bool next(int i, Unit& u) const {
        const long L = (long)i * G + c; if (L >= nwg) return false;
        int wgid = (int)L; { const int q = nwg / NXCD, r = nwg % NXCD, xcd = wgid % NXCD, off = wgid / NXCD; wgid = (xcd < r ? xcd * (q + 1) : r * (q + 1) + (xcd - r) * q) + off; }
        const int nig = WGM * nN, gid = wgid / nig, fm = gid * WGM, gsz = (nM - fm) < WGM ? (nM - fm) : WGM;
        u.pm = fm + ((wgid % nig) % gsz); u.pn = (wgid % nig) / gsz; return true;
    }
};

template <class Epi, class Sched>
DI void gemm_phase(LAS unsigned char* lds, const Gemm g, const Sched& S, const Epi& E, int wave_) {
    int tid_ = wave_ * 64 + lane_id(); asm volatile("" : "+v"(tid_));
    const int tid = tid_, wid = __builtin_amdgcn_readfirstlane(tid >> 6), lane = tid & 63, wr = wid >> 2, wc = wid & 3, fr = lane & 15, fq = lane >> 4;
    const int K = g.K, nt = K / BK;
    unsigned voffA[2], voffB[2];
#pragma unroll
    for (int i = 0; i < 2; ++i) { int R, C; stage_rc(tid * 16 + i * 8192, R, C); const int Rb = (R & ~31) + perm32(R & 31);
        voffA[i] = (unsigned)(R * g.lda + C) * 2u; voffB[i] = (unsigned)(Rb * g.ldb + C) * 2u; }
    const size_t kstepA = g.ksA, kstepB = g.ksB;
    const size_t hstepA = (size_t)HALF * g.lda * 2, tstepA = 2 * hstepA, hstepB = (size_t)HALF * g.ldb * 2, tstepB = 2 * hstepB;
    const unsigned ldsw = (unsigned)wid * 1024u;
    const int aoff = lds_byte(wr * 64 + fr, fq * 8), boff = lds_byte(wc * 32 + fr, fq * 8);
#define PG8_SA(b, h) (((b) * 2 + (h)) * HTB)
#define PG8_SB(b, h) ((4 + (b) * 2 + (h)) * HTB)
#define PG8_STAGE(bufoff, gbase, voff) do { _Pragma("unroll") for (int _i = 0; _i < 2; ++_i) \
        __builtin_amdgcn_global_load_lds((const unsigned*)((const char*)(gbase) + (voff)[_i]), (LAS unsigned*)(lds + (bufoff) + ldsw + _i * 8192), 16, 0, 0); } while (0)
#define PG8_LDA(dst, b, h) do { _Pragma("unroll") for (int m = 0; m < 4; ++m) _Pragma("unroll") for (int k = 0; k < 2; ++k) dst[m][k] = *(const LAS bf16x8*)(lds + PG8_SA(b, h) + aoff + m * 2048 + k * 1024); } while (0)
#define PG8_LDB(dst, b, h) do { _Pragma("unroll") for (int n = 0; n < 2; ++n) _Pragma("unroll") for (int k = 0; k < 2; ++k) dst[n][k] = *(const LAS bf16x8*)(lds + PG8_SB(b, h) + boff + n * 2048 + k * 1024); } while (0)
#define PG8_MMA(ai, bj, At, Bt) do { __builtin_amdgcn_s_setprio(1); _Pragma("unroll") for (int m = 0; m < 4; ++m) _Pragma("unroll") for (int n = 0; n < 2; ++n) _Pragma("unroll") for (int k = 0; k < 2; ++k) \
        acc[ai][bj][m][n] = __builtin_amdgcn_mfma_f32_16x16x32_bf16(Bt[n][k], At[m][k], acc[ai][bj][m][n], 0, 0, 0); __builtin_amdgcn_s_setprio(0); } while (0)
#define PG8_WAIT_V(n) asm volatile("s_waitcnt vmcnt(" #n ")" ::: "memory")
#define PG8_WAIT_L(n) asm volatile("s_waitcnt lgkmcnt(" #n ")" ::: "memory")
#define PG8_BAR __builtin_amdgcn_s_barrier()
#define PG8_SCHED __builtin_amdgcn_sched_barrier(0)
    Unit cur, nxt; int ui = 0;
    if (!S.next(0, cur)) return;
    f32x4 acc[2][2][4][2];
#pragma unroll
    for (int a = 0; a < 2; ++a)
#pragma unroll
        for (int b = 0; b < 2; ++b)
#pragma unroll
            for (int m = 0; m < 4; ++m)
#pragma unroll
                for (int n = 0; n < 2; ++n) acc[a][b][m][n] = (f32x4){0.f, 0.f, 0.f, 0.f};
    bf16x8 At[4][2], B0[2][2], B1[2][2];
    const char* cA = (const char*)g.A + (size_t)cur.pm * tstepA; const char* cB = (const char*)g.Bt + (size_t)cur.pn * tstepB;
    PG8_STAGE(PG8_SB(0, 0), cB, voffB); PG8_STAGE(PG8_SB(0, 1), cB + hstepB, voffB); PG8_STAGE(PG8_SA(0, 0), cA, voffA); PG8_STAGE(PG8_SA(0, 1), cA + hstepA, voffA);
    if (wr == 1) PG8_BAR;
    PG8_WAIT_V(2); PG8_BAR;
    PG8_STAGE(PG8_SB(1, 0), cB + kstepB, voffB); PG8_STAGE(PG8_SA(1, 0), cA + kstepA, voffA); PG8_STAGE(PG8_SB(1, 1), cB + hstepB + kstepB, voffB);
    PG8_WAIT_V(6); PG8_BAR;
    for (;;) {
        const bool has_next = S.next(ui + 1, nxt);
        const char* nA = has_next ? (const char*)g.A + (size_t)nxt.pm * tstepA : cA; const char* nB = has_next ? (const char*)g.Bt + (size_t)nxt.pn * tstepB : cB;
        for (int t = 0; t < nt; t += 2) {
            const bool last = (t == nt - 2);
            const char* a1 = cA + (size_t)(t + 1) * kstepA;
            const char* a2 = last ? nA : cA + (size_t)(t + 2) * kstepA; const char* b2 = last ? nB : cB + (size_t)(t + 2) * kstepB;
            const char* a3 = a2 + kstepA; const char* b3 = b2 + kstepB;
            PG8_LDB(B0, 0, 0); PG8_LDB(B1, 0, 1); PG8_SCHED; PG8_LDA(At, 0, 0); PG8_STAGE(PG8_SA(1, 1), a1 + hstepA, voffA);
            PG8_WAIT_V(8); PG8_WAIT_L(0); PG8_BAR; PG8_MMA(0, 0, At, B0); PG8_MMA(0, 1, At, B1); PG8_BAR; PG8_SCHED;
            PG8_LDA(At, 0, 1); PG8_STAGE(PG8_SB(0, 0), b2, voffB); PG8_STAGE(PG8_SB(0, 1), b2 + hstepB, voffB); PG8_STAGE(PG8_SA(0, 0), a2, voffA);
            PG8_WAIT_V(8); PG8_WAIT_L(0); PG8_BAR; PG8_MMA(1, 0, At, B0); PG8_MMA(1, 1, At, B1); PG8_BAR; PG8_SCHED;
            PG8_LDB(B0, 1, 0); PG8_LDB(B1, 1, 1); PG8_SCHED; PG8_LDA(At, 1, 0); PG8_STAGE(PG8_SA(0, 1), a2 + hstepA, voffA);
            PG8_WAIT_V(8); PG8_WAIT_L(0); PG8_BAR; PG8_MMA(0, 0, At, B0); PG8_MMA(0, 1, At, B1); PG8_BAR; PG8_SCHED;
            PG8_LDA(At, 1, 1); PG8_STAGE(PG8_SB(1, 0), b3, voffB); PG8_STAGE(PG8_SB(1, 1), b3 + hstepB, voffB); PG8_STAGE(PG8_SA(1, 0), a3, voffA);
            PG8_WAIT_V(8); PG8_WAIT_L(0); PG8_BAR; PG8_MMA(1, 0, At, B0); PG8_MMA(1, 1, At, B1); PG8_BAR; PG8_SCHED;
        }
        if (wr == 0) PG8_BAR;
        E(acc, cur, wr, wc, fr, fq);
        if (!has_next) break;
#pragma unroll
        for (int a = 0; a < 2; ++a)
#pragma unroll
            for (int b = 0; b < 2; ++b)
#pragma unroll
                for (int m = 0; m < 4; ++m)
#pragma unroll
                    for (int n = 0; n < 2; ++n) acc[a][b][m][n] = (f32x4){0.f, 0.f, 0.f, 0.f};
        cur = nxt; cA = nA; cB = nB; ++ui;
        if (wr == 1) PG8_BAR;
    }
    PG8_WAIT_V(0);
    PG8_BAR;
#undef PG8_SA
#undef PG8_SB
#undef PG8_STAGE
#undef PG8_LDA
#undef PG8_LDB
#undef PG8_MMA
#undef PG8_WAIT_V
#undef PG8_WAIT_L
#undef PG8_BAR
#undef PG8_SCHED
}

struct EpiRow {
    bf16_t* O; int ldc; const float* rowss; const float* qg; const float* kg; int mode; int blocked;
    DI void operator()(const f32x4 (&acc)[2][2][4][2], const Unit& u, int wr, int wc, int fr, int fq) const {
        const int row0 = u.pm * BM + wr * 64 + fr, col0 = u.pn * BM + 64 * wc + 8 * fq;
        int type; const float* gam = kg; float gsc = 1.f;
        if (mode == 1) { type = 1; gam = kg + u.pn * 192 + 128; }
        else if (u.pn < 4) { type = 0; const int hd = 4 * u.pn + wc; gam = qg + (hd < 6 ? 0 : (hd < 12 ? 64 : 128)); gsc = 0.125f * LOG2E; }
        else if (u.pn < 6) { type = 1; const int hd = 4 * (u.pn - 4) + wc; gam = kg + (hd < 6 ? 0 : 64); }
        else type = 2;
        f32x4 gv[2][2];
#pragma unroll
        for (int bj = 0; bj < 2; ++bj)
#pragma unroll
            for (int n = 0; n < 2; ++n) gv[bj][n] = (type < 2) ? *(const f32x4*)(gam + 32 * bj + 8 * fq + 4 * n) * gsc : (f32x4){1.f, 1.f, 1.f, 1.f};
        float rsv[2][4];
#pragma unroll
        for (int ai = 0; ai < 2; ++ai)
#pragma unroll
            for (int m = 0; m < 4; ++m) rsv[ai][m] = ((const GAS float*)rowss)[row0 + ai * HALF + m * 16];
#pragma unroll
        for (int ai = 0; ai < 2; ++ai)
#pragma unroll
            for (int m = 0; m < 4; ++m) {
                const int row = row0 + ai * HALF + m * 16;
                const float rs = __builtin_amdgcn_rsqf(rsv[ai][m] * (1.0f / 1024.0f) + RMS_EPS);
                f32x4 v[2][2]; float ss = 0.f;
#pragma unroll
                for (int bj = 0; bj < 2; ++bj)
#pragma unroll
                    for (int n = 0; n < 2; ++n) { v[bj][n] = acc[ai][bj][m][n] * rs; const f32x4 x = v[bj][n]; ss += (x[0] * x[0] + x[1] * x[1]) + (x[2] * x[2] + x[3] * x[3]); }
                if (type < 2) {
                    ss += __shfl_xor(ss, 16); ss = half_sum(ss);
                    const float rn = __builtin_amdgcn_rsqf(ss * (1.0f / 64.0f) + RMS_EPS);
#pragma unroll
                    for (int bj = 0; bj < 2; ++bj)
#pragma unroll
                        for (int n = 0; n < 2; ++n) v[bj][n] = v[bj][n] * rn * gv[bj][n];
                } else {
#pragma unroll
                    for (int bj = 0; bj < 2; ++bj)
#pragma unroll
                        for (int n = 0; n < 2; ++n)
#pragma unroll
                            for (int j = 0; j < 4; ++j) { const float x = v[bj][n][j]; v[bj][n][j] = x * __builtin_amdgcn_rcpf(1.0f + __builtin_amdgcn_exp2f(-x * LOG2E)); }
                }
                GAS bf16_t* rowp = blocked ? (GAS bf16_t*)O + ((size_t)(4 * u.pn + wc) * NTOK + row) * 64 + 8 * fq : (GAS bf16_t*)O + (size_t)row * ldc + col0;
#pragma unroll
                for (int bj = 0; bj < 2; ++bj) { u32x4 w; w.x = pk2(v[bj][0][0], v[bj][0][1]); w.y = pk2(v[bj][0][2], v[bj][0][3]); w.z = pk2(v[bj][1][0], v[bj][1][1]); w.w = pk2(v[bj][1][2], v[bj][1][3]);
                    *(GAS u32x4*)(rowp + 32 * bj) = w; }
            }
    }
};
struct EpiCol {
    bf16_t* O; int ldc; const float* colss; int blocked;
    DI void operator()(const f32x4 (&acc)[2][2][4][2], const Unit& u, int wr, int wc, int fr, int fq) const {
        const int row0 = u.pm * BM + wr * 64 + fr, col0 = u.pn * BM + 32 * wc + 8 * fq;
        f32x4 rs[2][2];
#pragma unroll
        for (int bj = 0; bj < 2; ++bj)
#pragma unroll
            for (int n = 0; n < 2; ++n) { const f32x4 s = *(const GAS f32x4*)((const GAS float*)colss + col0 + HALF * bj + 4 * n);
#pragma unroll
                for (int j = 0; j < 4; ++j) rs[bj][n][j] = __builtin_amdgcn_rsqf(s[j] * (1.0f / 1024.0f) + RMS_EPS); }
#pragma unroll
        for (int ai = 0; ai < 2; ++ai)
#pragma unroll
            for (int m = 0; m < 4; ++m) { const int row = row0 + ai * HALF + m * 16;
                GAS bf16_t* rowp = blocked ? (GAS bf16_t*)O + ((size_t)(col0 >> 6) * 512 + row) * 64 + (col0 & 63) : (GAS bf16_t*)O + (size_t)row * ldc + col0;
                const size_t bjstep = blocked ? (size_t)2 * 32768 : (size_t)HALF;
#pragma unroll
                for (int bj = 0; bj < 2; ++bj) { const f32x4 v0 = acc[ai][bj][m][0] * rs[bj][0], v1 = acc[ai][bj][m][1] * rs[bj][1];
                    u32x4 w; w.x = pk2(v0[0], v0[1]); w.y = pk2(v0[2], v0[3]); w.z = pk2(v1[0], v1[1]); w.w = pk2(v1[2], v1[3]);
                    *(GAS u32x4*)(rowp + bjstep * bj) = w; } }
    }
};
struct EpiOut {
    const float* xin_p; const float* xin_s; float* out; bf16_t* xb; float* ss_next; int last;
    DI void operator()(const f32x4 (&acc)[2][2][4][2], const Unit& u, int wr, int wc, int fr, int fq) const {
        const int row0 = u.pm * BM + wr * 64 + fr, col0 = u.pn * BM + 32 * wc + 8 * fq;
        const GAS float* xin = (const GAS float*)((u.pm < NTOK_P / BM) ? xin_p : xin_s);
        GAS float* outg = (GAS float*)out; GAS bf16_t* xbg = (GAS bf16_t*)xb;
#pragma unroll
        for (int ai = 0; ai < 2; ++ai) {
            f32x4 xv[4][2][2];
#pragma unroll
            for (int m = 0; m < 4; ++m) { const size_t off = (size_t)(row0 + ai * HALF + m * 16) * DM + col0;
#pragma unroll
                for (int bj = 0; bj < 2; ++bj)
#pragma unroll
                    for (int n = 0; n < 2; ++n) xv[m][bj][n] = *(const GAS f32x4*)(xin + off + HALF * bj + 4 * n); }
#pragma unroll
            for (int m = 0; m < 4; ++m) { const int row = row0 + ai * HALF + m * 16; const size_t off = (size_t)row * DM + col0; float ss = 0.f;
#pragma unroll
                for (int bj = 0; bj < 2; ++bj) { f32x4 v[2];
#pragma unroll
                    for (int n = 0; n < 2; ++n) { v[n] = xv[m][bj][n] + acc[ai][bj][m][n]; __builtin_nontemporal_store(v[n], (GAS f32x4*)(outg + off + HALF * bj + 4 * n));
                        ss += (v[n][0] * v[n][0] + v[n][1] * v[n][1]) + (v[n][2] * v[n][2] + v[n][3] * v[n][3]); }
                    if (!last) { u32x4 w; w.x = pk2(v[0][0], v[0][1]); w.y = pk2(v[0][2], v[0][3]); w.z = pk2(v[1][0], v[1][1]); w.w = pk2(v[1][2], v[1][3]); *(GAS u32x4*)(xbg + off + HALF * bj) = w; } }
                if (!last) { ss += __shfl_xor(ss, 16); ss = half_sum(ss); if (fq == 0) atomicAdd(ss_next + row, ss); } }
        }
    }
};
}

namespace att {
#define MFMA32(a, b, c) __builtin_amdgcn_mfma_f32_32x32x16_bf16((a), (b), (c), 0, 0, 0)
constexpr int TAB_OFF = 131072;
struct TaskP {
    bf16_t* qrow_base;
    const bf16_t* grow_base;
    const bf16_t* kbase;
    const bf16_t* vbase;
    int ldk, ldv, nt;
    float minit, linit;
    int rel_row0, tabh;
    int vk32;
    int dq0, jofs; float slope;
};
template <int KIND>
DI void attn_task(const TaskP& P, const LAS float* tab, LAS unsigned char* wl, int lane) {
    const int q = lane & 31, hh = lane >> 5;
    const int pil = (q & 0x13) | ((q & 4) << 1) | ((q & 8) >> 1);
    GAS bf16_t* qrow = (GAS bf16_t*)P.qrow_base + q * QLD;
    bf16x8 qf[2][4];
#pragma unroll
    for (int u = 0; u < 2; ++u)
#pragma unroll
        for (int ks = 0; ks < 4; ++ks) qf[u][ks] = *(const GAS bf16x8*)(qrow + (32 * u) * QLD + 32 * hh + 8 * ks);
    f32x16 oa[2], ob[2];
#pragma unroll
    for (int u = 0; u < 2; ++u)
#pragma unroll
        for (int i = 0; i < 16; ++i) { oa[u][i] = 0.f; ob[u][i] = 0.f; }
    float mrun[2], lrun[2];
    mrun[0] = mrun[1] = P.minit; lrun[0] = lrun[1] = (hh == 0) ? P.linit : 0.f;
    const int l3 = lane >> 3, l4 = lane >> 4;
    const int vc = (lane & 3) ^ (l4 & 3);
    const GAS bf16_t* kg = (const GAS bf16_t*)P.kbase;
    const GAS bf16_t* vg0 = (const GAS bf16_t*)P.vbase;
    const unsigned kro0 = (unsigned)(pil * 128 + (((4 * hh) ^ ((pil >> 1) & 7)) * 16));
    const unsigned vro0 = (unsigned)(4096 + pil * 64 + ((hh ^ ((pil >> 2) & 3)) * 16));
    const int kca = (lane & 7) ^ (l4 & 7);
    const unsigned kof0 = (unsigned)(l3 * P.ldk + 8 * kca) * 2u;
    const unsigned vof0 = (unsigned)((lane >> 2) * P.ldv + ((KIND == 0) ? ((vc >> 1) * 32768 + 8 * (vc & 1)) : (8 * vc))) * 2u;
#define ATT_RP(t_) ((((t_) >> 2) - (P.tabh >> 12)) & 3)
#define ATT_TILEKEY(t_) ((KIND == 0) ? (128 * ATT_RP(t_) + 16 * ((t_) & 3)) : (32 * (t_)))
#define ATT_KROW(i_) ((KIND == 0) ? (((i_) >> 1) * 64 + 8 * ((i_) & 1)) : (8 * (i_)))
#define ATT_PIECE_K(t_, buf_, i_) do { const GAS char* kt_ = (const GAS char*)(kg + (size_t)(ATT_TILEKEY(t_) + ATT_KROW(i_)) * P.ldk); \
        __builtin_amdgcn_global_load_lds((const GAS unsigned*)(kt_ + (((i_) & 1) ? (kof0 ^ 64u) : kof0)), (LAS unsigned*)(wl + (buf_) * 8192 + (i_) * 1024), 16, 0, 0); } while (0)
#define ATT_TILEKEY_V(t_) ((KIND == 0) ? (65536 * ATT_RP(t_) + 16 * ((t_) & 3)) : (KIND == 1) ? ((((P.vk32 + (t_)) >> 1) * 32768) + ((P.vk32 + (t_)) & 1) * 32) : (32 * (t_)))
#define ATT_PIECE_V(t_, buf_, i_) do { const GAS char* vt_ = (const GAS char*)(vg0 + (size_t)(16 * (i_)) * P.ldv + ATT_TILEKEY_V(t_)); \
        __builtin_amdgcn_global_load_lds((const GAS unsigned*)(vt_ + vof0), (LAS unsigned*)(wl + (buf_) * 8192 + 4096 + (i_) * 1024), 16, 0, 0); } while (0)
#pragma unroll
    for (int i = 0; i < 4; ++i) ATT_PIECE_K(0, 0, i);
#pragma unroll
    for (int i = 0; i < 4; ++i) ATT_PIECE_V(0, 0, i);
    if (P.nt > 1) {
#pragma unroll
        for (int i = 0; i < 4; ++i) ATT_PIECE_K(1, 1, i);
    }
    for (int t = 0; t < P.nt; ++t) {
        asm volatile("" ::: "memory");
        if (t + 1 < P.nt) asm volatile("s_waitcnt vmcnt(8)" ::: "memory"); else asm volatile("s_waitcnt vmcnt(4)" ::: "memory");
        const LAS unsigned char* bb = wl + (t & 1) * 8192;
        const bool moreK = (t + 2 < P.nt), moreV = (t + 1 < P.nt);
        bool act[2];
#pragma unroll
        for (int u = 0; u < 2; ++u) { act[u] = true;
            if (KIND == 0) { const int cb = t & 3; act[u] = !(cb < u || cb > u + 2); }
            if (KIND == 1) { const int j = P.jofs + t; act[u] = !(j < u || j > u + 8); } }
        f32x16 sv[2];
        {
            bf16x8 kf[4];
#pragma unroll
            for (int ks = 0; ks < 4; ++ks) kf[ks] = *(const LAS bf16x8*)(bb + (kro0 ^ (16u * ks)));
#pragma unroll
            for (int u = 0; u < 2; ++u) {
#pragma unroll
                for (int i = 0; i < 16; ++i) sv[u][i] = 0.f;
                if (act[u]) {
                    __builtin_amdgcn_s_setprio(1);
#pragma unroll
                    for (int ks = 0; ks < 4; ++ks) sv[u] = MFMA32(kf[ks], qf[u][ks], sv[u]);
                    __builtin_amdgcn_s_setprio(0);
                }
            }
        }
        asm volatile("s_waitcnt lgkmcnt(0)" ::: "memory");
        bf16x8 pb[2][2];
#pragma unroll
        for (int u = 0; u < 2; ++u) {
            f32x16 s = sv[u];
            float mn = 0.f;
            if (act[u]) {
                if (KIND == 0) {
                    const int rp = ATT_RP(t), cb = t & 3;
                    const int qc = 32 * u + q;
                    const int cs = qc - 8 < 0 ? 0 : (qc - 8 > 48 ? 48 : qc - 8);
                    const int kcb = 16 * cb + 8 * hh;
                    const int db = kcb - qc + 15, mb = kcb - cs;
                    const LAS float* tr0 = tab + ((P.tabh & 4095) + (P.rel_row0 + 2 * rp) * 32 + db);
                    const unsigned taddr = (unsigned)(size_t)tr0;
#pragma unroll
                    for (int hb = 0; hb < 2; ++hb) {
                        float bz[8]; const unsigned ta2 = taddr + 128u * hb;
                        asm volatile("ds_read_b32 %0, %8\n\tds_read_b32 %1, %8 offset:4\n\tds_read_b32 %2, %8 offset:8\n\tds_read_b32 %3, %8 offset:12\n\t"
                                     "ds_read_b32 %4, %8 offset:16\n\tds_read_b32 %5, %8 offset:20\n\tds_read_b32 %6, %8 offset:24\n\tds_read_b32 %7, %8 offset:28\n\t"
                                     "s_waitcnt lgkmcnt(0)"
                                     : "=&v"(bz[0]), "=&v"(bz[1]), "=&v"(bz[2]), "=&v"(bz[3]), "=&v"(bz[4]), "=&v"(bz[5]), "=&v"(bz[6]), "=&v"(bz[7])
                                     : "v"(ta2) : "memory");
#pragma unroll
                        for (int ci = 0; ci < 8; ++ci) { const bool valid = (unsigned)(mb + ci) < 16u;
                            s[8 * hb + ci] = valid ? s[8 * hb + ci] + bz[ci] : -INFINITY; }
                    }
                } else if (KIND == 1) {
                    const float fdq = (float)(P.dq0 + 32 * u + q - 8 * hh - 32 * t);
                    const int jrel = P.jofs + t - u;
                    if (jrel >= 1 && jrel <= 7) {
#pragma unroll
                        for (int i = 0; i < 16; ++i) { const float ci = (float)((i & 7) + 16 * (i >> 3)); s[i] = s[i] - P.slope * fabsf(fdq - ci); }
                    } else {
#pragma unroll
                        for (int i = 0; i < 16; ++i) { const float ci = (float)((i & 7) + 16 * (i >> 3));
                            const float ad = fabsf(fdq - ci);
                            s[i] = ad <= 128.f ? s[i] - P.slope * ad : -INFINITY; }
                    }
                }
                float mx = fmaxf(s[0], s[1]);
#pragma unroll
                for (int i = 2; i < 16; ++i) mx = fmaxf(mx, s[i]);
                mx = half_max(mx);
                const float mold = mrun[u];
                mn = (mx > mold + 8.f) ? mx : mold;
                if (__builtin_amdgcn_ballot_w64(mn != mold)) {
                    const float alpha = __builtin_amdgcn_exp2f(mold - mn);
                    lrun[u] *= alpha;
#pragma unroll
                    for (int i = 0; i < 16; ++i) { oa[u][i] *= alpha; ob[u][i] *= alpha; }
                    mrun[u] = mn;
                }
            }
            __builtin_amdgcn_sched_barrier(0);
            if (moreK) { ATT_PIECE_K(t + 2, t & 1, 2 * u); ATT_PIECE_K(t + 2, t & 1, 2 * u + 1); }
            __builtin_amdgcn_sched_barrier(0);
            if (act[u]) {
                float ps0 = 0.f, ps1 = 0.f;
#pragma unroll
                for (int i = 0; i < 16; i += 2) { s[i] = __builtin_amdgcn_exp2f(s[i] - mn); s[i + 1] = __builtin_amdgcn_exp2f(s[i + 1] - mn); ps0 += s[i]; ps1 += s[i + 1]; }
                lrun[u] += ps0 + ps1;
#pragma unroll
                for (int sx = 0; sx < 2; ++sx) { u32x4 w; w.x = pk2(s[8 * sx], s[8 * sx + 1]); w.y = pk2(s[8 * sx + 2], s[8 * sx + 3]); w.z = pk2(s[8 * sx + 4], s[8 * sx + 5]); w.w = pk2(s[8 * sx + 6], s[8 * sx + 7]);
                    pb[u][sx] = __builtin_bit_cast(bf16x8, w); }
            }
            __builtin_amdgcn_sched_barrier(0);
            if (moreV) { ATT_PIECE_V(t + 1, (t + 1) & 1, 2 * u); ATT_PIECE_V(t + 1, (t + 1) & 1, 2 * u + 1); }
            __builtin_amdgcn_sched_barrier(0);
        }
        if (moreK) asm volatile("s_waitcnt vmcnt(8)" ::: "memory");
        else if (moreV) asm volatile("s_waitcnt vmcnt(4)" ::: "memory");
        else asm volatile("s_waitcnt vmcnt(0)" ::: "memory");
        {
            bf16x8 vf[4];
            vf[0] = *(const LAS bf16x8*)(bb + vro0); vf[1] = *(const LAS bf16x8*)(bb + (vro0 ^ 32u));
            vf[2] = *(const LAS bf16x8*)(bb + vro0 + 2048); vf[3] = *(const LAS bf16x8*)(bb + (vro0 ^ 32u) + 2048);
#pragma unroll
            for (int u = 0; u < 2; ++u) {
                if (!act[u]) continue;
                __builtin_amdgcn_s_setprio(1);
                oa[u] = MFMA32(vf[0], pb[u][0], oa[u]); oa[u] = MFMA32(vf[1], pb[u][1], oa[u]);
                ob[u] = MFMA32(vf[2], pb[u][0], ob[u]); ob[u] = MFMA32(vf[3], pb[u][1], ob[u]);
                __builtin_amdgcn_s_setprio(0);
            }
        }
        asm volatile("s_waitcnt lgkmcnt(0)" ::: "memory");
    }
#undef ATT_PIECE_K
#undef ATT_TILEKEY
#undef ATT_RP
#undef ATT_TILEKEY_V
#undef ATT_KROW
#undef ATT_PIECE_V
#pragma unroll
    for (int u = 0; u < 2; ++u) {
        const float lt = half_sum(lrun[u]);
        const float inv = __builtin_amdgcn_rcpf(lt);
        const GAS bf16_t* grow = (const GAS bf16_t*)P.grow_base + (32 * u + q) * QLD;
        GAS bf16_t* orow = qrow + (32 * u) * QLD;
#pragma unroll
        for (int db = 0; db < 2; ++db)
#pragma unroll
            for (int g = 0; g < 2; ++g) { const int d0 = 32 * db + 16 * g + 8 * hh;
                const u32x4 gt = *(const GAS u32x4*)(grow + d0);
                float ov[8];
#pragma unroll
                for (int j = 0; j < 8; ++j) ov[j] = (db == 0 ? oa[u][8 * g + j] : ob[u][8 * g + j]) * inv;
                u32x4 w; w.x = pk2(ov[0] * bflo(gt.x), ov[1] * bfhi(gt.x)); w.y = pk2(ov[2] * bflo(gt.y), ov[3] * bfhi(gt.y));
                w.z = pk2(ov[4] * bflo(gt.z), ov[5] * bfhi(gt.z)); w.w = pk2(ov[6] * bflo(gt.w), ov[7] * bfhi(gt.w));
                *(GAS u32x4*)(orow + d0) = w; }
    }
}
}


#define XB_TMO      128
#define XB_XCNT(j)  (256  + 64 * (j))
#define XB_XSUB(j)  (1280 + 64 * (j))
#define XB_XGEN(j)  (2304 + 64 * (j))
#define XB_TOP      3328
#define XB_TOPGEN   3392
#define XCD_BAR_WORDS 3456
#define XB_SPIN_CAP (1u << 22)
DI unsigned xb_ld(unsigned* p)              { return __hip_atomic_load(p, __ATOMIC_RELAXED, __HIP_MEMORY_SCOPE_AGENT); }
DI unsigned xb_add(unsigned* p, unsigned v) { return __hip_atomic_fetch_add(p, v, __ATOMIC_RELAXED, __HIP_MEMORY_SCOPE_AGENT); }
DI unsigned xb_xcc_id() { return (unsigned)__builtin_amdgcn_s_getreg((3 << 11) | 20) & 0xFu; }
#define XB_SPIN(cond, bar) do { unsigned _sp = 0; while (cond) { __builtin_amdgcn_s_sleep(1); \
    if ((++_sp & 255u) == 0u) { if (xb_ld(&(bar)[XB_TMO])) break; if (_sp > XB_SPIN_CAP) { atomicAdd(&(bar)[XB_TMO], 1u); break; } } } } while (0)
struct XcdBarrier { unsigned* bar; unsigned x; volatile LAS unsigned* st; };
DI XcdBarrier xcd_barrier_post(unsigned* bar, volatile LAS unsigned* st, bool t0) {
    XcdBarrier b; b.bar = bar; b.x = xb_xcc_id(); b.st = st;
    if (t0) (void)xb_add(&bar[XB_XCNT(b.x)], 1u);
    return b;
}
DI void xcd_barrier_complete(unsigned* bar, unsigned x, unsigned& nloc, unsigned& nx) {
    const unsigned G = gridDim.x * gridDim.y * gridDim.z;
    unsigned sum, cnt, mine, sp = 0u;
    for (;;) {
        sum = 0u; cnt = 0u; mine = 0u;
#pragma unroll
        for (unsigned j = 0; j < 16; ++j) { const unsigned c = xb_ld(&bar[XB_XCNT(j)]); sum += c; cnt += (c > 0u) ? 1u : 0u; mine = (j == x) ? c : mine; }
        if (sum == G) break;
        __builtin_amdgcn_s_sleep(1);
        if ((++sp & 255u) == 0u) { if (xb_ld(&bar[XB_TMO])) break; if (sp > XB_SPIN_CAP) { atomicAdd(&bar[XB_TMO], 1u); break; } }
    }
    nloc = mine > 0u ? mine : 1u; nx = cnt > 0u ? cnt : 1u;
}
DI void xcd_barrier(const XcdBarrier& b, int wave_) {
    const bool t0 = (wave_ == 0) && (lane_id() == 0);
    asm volatile("s_waitcnt vmcnt(0)" ::: "memory");
    __syncthreads();
    if (t0) {
        unsigned* bar = b.bar;
        __builtin_amdgcn_s_waitcnt(0);
        unsigned nloc = b.st[0], nx = b.st[1];
        if (nloc == 0u) { xcd_barrier_complete(bar, b.x, nloc, nx); b.st[0] = nloc; b.st[1] = nx; }
        const unsigned old = xb_add(&bar[XB_XSUB(b.x)], 1u);
        const unsigned gen = old / nloc;
        if (old + 1u == (gen + 1u) * nloc) {
            __builtin_amdgcn_fence(__ATOMIC_RELEASE, "agent");
            asm volatile("s_waitcnt vmcnt(0)" ::: "memory");
            const unsigned og = xb_add(&bar[XB_TOP], 1u);
            const unsigned tg = og / nx;
            if (og + 1u == (tg + 1u) * nx) xb_add(&bar[XB_TOPGEN], 1u);
            else XB_SPIN(xb_ld(&bar[XB_TOPGEN]) == tg, bar);
            __builtin_amdgcn_fence(__ATOMIC_ACQUIRE, "agent");
            xb_add(&bar[XB_XGEN(b.x)], 1u);
            asm volatile("s_waitcnt vmcnt(0)" ::: "memory");
        } else {
            XB_SPIN(xb_ld(&bar[XB_XGEN(b.x)]) == gen, bar);
            __builtin_amdgcn_fence(__ATOMIC_ACQUIRE, "agent");
            asm volatile("s_waitcnt vmcnt(0)" ::: "memory");
        }
    }
    __syncthreads();
}
constexpr size_t WS_BAR = 901120;
constexpr size_t WS_TAB = 950272;
constexpr size_t WS_CTR = WS_BAR + 13824;
constexpr int LDS_BARST = 143360;

struct Args {
    const float *x_prompt, *x_sample, *mem_prompt, *mem_sample, *norm_g, *w_in, *q_norm_g, *k_norm_g, *rpb, *sink, *mem_norm_g, *w_mem_kv, *w_out;
    float* out; unsigned char* ws;
};
#define LDS_WAIT() asm volatile("s_waitcnt lgkmcnt(0)" ::: "memory")
DI float wave_sum(float v) {
#pragma unroll
    for (int o = 1; o < 64; o <<= 1) v += __shfl_xor(v, o);
    return v;
}
DI void p0_transpose_item(const float* W, int ldw, int srccol0, bf16_t* WT, int dstrow0, const float* g, LAS float* scr, int kb, int lane) {
    const int k0 = 64 * kb;
    float wv[32];
    const GAS float* Wg = (const GAS float*)W + (size_t)(k0 + (lane >> 5)) * ldw + srccol0 + (lane & 31);
#pragma unroll
    for (int i = 0; i < 32; ++i) wv[i] = Wg[(size_t)(2 * i) * ldw];
    const float g0 = g ? ((const GAS float*)g)[k0 + (lane & 63)] : 1.f;
#pragma unroll
    for (int i = 0; i < 32; ++i) { const int kk = 2 * i + (lane >> 5); const float sc = __shfl(g0, kk); scr[kk * 33 + (lane & 31)] = wv[i] * sc; }
    LDS_WAIT(); asm volatile("" ::: "memory");
    const int c = lane & 7;
#pragma unroll
    for (int j = 0; j < 4; ++j) { const int n = (lane >> 3) + 8 * j; const LAS float* s = scr + (8 * c) * 33 + n;
        u32x4 o; o.x = pk2(s[0 * 33], s[1 * 33]); o.y = pk2(s[2 * 33], s[3 * 33]); o.z = pk2(s[4 * 33], s[5 * 33]); o.w = pk2(s[6 * 33], s[7 * 33]);
        *(u32x4*)(WT + (size_t)(dstrow0 + n) * 1024 + k0 + 8 * c) = o; }
    LDS_WAIT(); asm volatile("" ::: "memory");
}
DI void rows4_to_bf16(const float* src, bf16_t* dst, float* ssq, int m0, int st, int lane) {
    f32x4 v[4][4]; float sq[4];
#pragma unroll
    for (int r = 0; r < 4; ++r) { const GAS f32x4* xr = (const GAS f32x4*)(src + (size_t)(m0 + r * st) * DM) + lane;
#pragma unroll
        for (int j = 0; j < 4; ++j) v[r][j] = xr[64 * j]; }
#pragma unroll
    for (int r = 0; r < 4; ++r) { sq[r] = 0.f;
#pragma unroll
        for (int j = 0; j < 4; ++j) sq[r] += (v[r][j].x * v[r][j].x + v[r][j].y * v[r][j].y) + (v[r][j].z * v[r][j].z + v[r][j].w * v[r][j].w);
        sq[r] = wave_sum(sq[r]);
        GAS u32x2* o8 = (GAS u32x2*)(dst + (size_t)(m0 + r * st) * DM) + lane;
#pragma unroll
        for (int j = 0; j < 4; ++j) { u32x2 w; w.x = pk2(v[r][j].x, v[r][j].y); w.y = pk2(v[r][j].z, v[r][j].w); o8[64 * j] = w; }
        if (lane == 0) ((GAS float*)ssq)[m0 + r * st] = sq[r]; }
}
DI int segmap(int c) {
    if (c < 384) return c;
    if (c < 768) return 1536 + (c - 384);
    if (c < 1024) return 2560 + (c - 768);
    if (c < 1408) return 384 + (c - 1024);
    if (c < 1536) return 1920 + (c - 1408);
    if (c < 1920) return 1152 + (c - 1536);
    if (c < 2304) return 2176 + (c - 1920);
    return 2816 + (c - 2304);
}

__global__ void __launch_bounds__(512, 2) hymba_fwd(Args a) {
    extern __shared__ __attribute__((aligned(16))) unsigned char lds_raw[];
    LAS unsigned char* lds = (LAS unsigned char*)lds_raw;
    cg::grid_group grid = cg::this_grid();
    const int wave = __builtin_amdgcn_readfirstlane((int)threadIdx.x >> 6);
    const int lane = lane_id(), tid = wave * 64 + lane;
    const int G = gridDim.x, bx = blockIdx.x;
    const int gw = bx * 8 + wave, NGW = G * 8;
    unsigned char* ws = a.ws;
    float* ROWSS = (float*)(ws + WS_ROWSS); float* MEMSS = (float*)(ws + WS_MEMSS);
    bf16_t* WIN = (bf16_t*)(ws + WS_WIN); bf16_t* WOUT = (bf16_t*)(ws + WS_WOUT); bf16_t* WMK = (bf16_t*)(ws + WS_WMK); bf16_t* WMV = (bf16_t*)(ws + WS_WMV);
    bf16_t* MEMB = (bf16_t*)(ws + WS_MEMB); bf16_t* MEMK = (bf16_t*)(ws + WS_MEMK); bf16_t* MEMVT = (bf16_t*)(ws + WS_MEMVT);
    bf16_t* XB = (bf16_t*)(ws + WS_XB); bf16_t* PROJ = (bf16_t*)(ws + WS_PROJ); bf16_t* VT = (bf16_t*)(ws + WS_VT);

#ifdef PROBE_SEL
    unsigned long long tq[4] = {0, 0, 0, 0}; unsigned long long tlast = __builtin_amdgcn_s_memrealtime();
#define STAMP(k) do { const unsigned long long tnow = __builtin_amdgcn_s_memrealtime(); tq[k] += tnow - tlast; tlast = tnow; } while (0)
#else
#define STAMP(k) do {} while (0)
#endif
    if (tid == 0) { ((volatile LAS unsigned*)(lds + LDS_BARST))[0] = 0u; ((volatile LAS unsigned*)(lds + LDS_BARST))[1] = 0u; }
    __syncthreads();
    const XcdBarrier xbar = xcd_barrier_post((unsigned*)(a.ws + WS_BAR), (volatile LAS unsigned*)(lds + LDS_BARST), tid == 0);
    {
        LAS float* scr = (LAS float*)(lds + wave * 16384);
        constexpr int I_IN = DEPTH * 96 * 16, I_OUT = DEPTH * 32 * 16, I_MK = DEPTH * 8 * 16, I_MV = I_MK, NITEMS = I_IN + I_OUT + I_MK + I_MV;
        for (int it = gw; it < NITEMS; it += NGW) {
            int r = it;
            if (r < I_IN) { const int l = r / 1536, rem = r % 1536, nb = rem >> 4, kb = rem & 15; int src;
                if (nb < 80) { const int R0 = 32 * nb, pn = R0 >> 8, p = R0 & 255, bj = p >> 7, hd = (p >> 5) & 3; src = segmap(256 * pn + 64 * hd + 32 * bj); }
                else { const int vr = 32 * (nb - 80); src = vr < 384 ? 768 + vr : 2048 + (vr - 384); }
                p0_transpose_item(a.w_in + (size_t)l * 1024 * 3072, 3072, src, WIN + (size_t)l * 3072 * 1024, 32 * nb, a.norm_g + l * 1024, scr, kb, lane); continue; }
            r -= I_IN;
            if (r < I_OUT) { const int l = r / 512, rem = r % 512, nb = rem >> 4, kb = rem & 15;
                p0_transpose_item(a.w_out + (size_t)l * 1024 * 1024, 1024, 32 * nb, WOUT + (size_t)l * 1024 * 1024, 32 * nb, nullptr, scr, kb, lane); continue; }
            r -= I_OUT;
            if (r < I_MK) { const int l = r / 128, rem = r % 128, nb = rem >> 4, kb = rem & 15; const int p = 32 * nb, bj = p >> 7, hd = (p >> 5) & 3;
                p0_transpose_item(a.w_mem_kv + (size_t)l * 1024 * 512, 512, 64 * hd + 32 * bj, WMK + (size_t)l * 256 * 1024, 32 * nb, a.mem_norm_g + l * 1024, scr, kb, lane); continue; }
            r -= I_MK;
            { const int l = r / 128, rem = r % 128, nb = rem >> 4, kb = rem & 15;
                p0_transpose_item(a.w_mem_kv + (size_t)l * 1024 * 512, 512, 256 + 32 * nb, WMV + (size_t)l * 256 * 1024, 32 * nb, a.mem_norm_g + l * 1024, scr, kb, lane); }
        }
        for (int m = gw; m < NTOK_P / 4; m += NGW) rows4_to_bf16(a.x_prompt, XB, ROWSS, m, NTOK_P / 4, lane);
        for (int m = gw; m < (NTOK - NTOK_P) / 4; m += NGW) rows4_to_bf16(a.x_sample, XB + (size_t)NTOK_P * DM, ROWSS + NTOK_P, m, (NTOK - NTOK_P) / 4, lane);
        for (int m = gw; m < 1024 / 4; m += NGW) rows4_to_bf16(a.mem_prompt, MEMB, MEMSS, m, 1024 / 4, lane);
        for (int m = gw; m < 4096 / 4; m += NGW) rows4_to_bf16(a.mem_sample, MEMB + (size_t)1024 * DM, MEMSS + 1024, m, 4096 / 4, lane);
        for (int i = bx * 512 + tid; i < 3 * NTOK; i += G * 512) ROWSS[NTOK + i] = 0.f;
        for (int i = bx * 512 + tid; i < DEPTH * 2880; i += G * 512) { const int ll = i / 2880, r0_ = i % 2880, h = r0_ / 480, rem = r0_ % 480, rr = rem >> 5, c = rem & 31;
            ((float*)(a.ws + WS_TAB))[i] = c < 31 ? a.rpb[(size_t)((ll * 6 + h) * 15 + rr) * 31 + c] * LOG2E : 0.f; }
    }
    if (a.ws == nullptr) grid.sync();
    xcd_barrier(xbar, wave);
    STAMP(0);

    {
        pg8::Gemm g{MEMB, WMK, NMEMTOK, 1024, 1024, 1024, 1024, 128, 128}; pg8::StaticOrder S; S.init(NMEMTOK, 1024, G, bx);
        pg8::EpiRow E{MEMK, 1024, MEMSS, a.q_norm_g, a.k_norm_g, 1, 0};
        pg8::gemm_phase<pg8::EpiRow, pg8::StaticOrder>(lds, g, S, E, wave);
    }
    {
        pg8::Gemm g{WMV, MEMB, 1024, NMEMTOK, 1024, 1024, 1024, 128, 128}; pg8::StaticOrder S; S.init(1024, NMEMTOK, G, (bx + 176) % G);
        pg8::EpiCol E{MEMVT, LDMVT, MEMSS, 0};
        pg8::gemm_phase<pg8::EpiCol, pg8::StaticOrder>(lds, g, S, E, wave);
    }

#pragma unroll 1
    for (int l = 0; l < DEPTH; ++l) {
        unsigned char* ws = a.ws; asm volatile("" : "+s"(ws));
        float* ROWSS = (float*)(ws + WS_ROWSS);
        bf16_t* WIN = (bf16_t*)(ws + WS_WIN); bf16_t* WOUT = (bf16_t*)(ws + WS_WOUT);
        bf16_t* MEMK = (bf16_t*)(ws + WS_MEMK); bf16_t* MEMVT = (bf16_t*)(ws + WS_MEMVT);
        bf16_t* XB = (bf16_t*)(ws + WS_XB); bf16_t* PROJ = (bf16_t*)(ws + WS_PROJ); bf16_t* VT = (bf16_t*)(ws + WS_VT);
        {
            pg8::Gemm g{XB, WIN + (size_t)l * 3072 * 1024, NTOK, 2560, 1024, 1024, 1024, 128, 128}; pg8::StaticOrder S; S.init(NTOK, 2560, G, bx);
            pg8::EpiRow E{PROJ, LDP, ROWSS + (size_t)l * NTOK, a.q_norm_g + l * 192, a.k_norm_g + l * 192, 0, 1};
            pg8::gemm_phase<pg8::EpiRow, pg8::StaticOrder>(lds, g, S, E, wave);
        }
        {
            pg8::Gemm g{WIN + (size_t)l * 3072 * 1024 + (size_t)2560 * 1024, XB, 512, NTOK, 1024, 1024, 1024, 128, 128}; pg8::StaticOrder S; S.init(512, NTOK, G, (bx + G / 2) % G);
            pg8::EpiCol E{VT, LDVT, ROWSS + (size_t)l * NTOK, 1};
            pg8::gemm_phase<pg8::EpiCol, pg8::StaticOrder>(lds, g, S, E, wave);
        }
        xcd_barrier(xbar, wave);
        STAMP(1);

        {
            int tid2 = wave * 64 + lane_id(); asm volatile("" : "+v"(tid2));
            const int tid = tid2, lane = tid & 63;
            LAS float* tab = (LAS float*)(lds + att::TAB_OFF);
            for (int i = tid; i < 720; i += 512) ((LAS f32x4*)tab)[i] = ((const GAS f32x4*)(ws + WS_TAB))[l * 720 + i];
            __syncthreads();
            LAS unsigned char* wl = lds + wave * 16384;
            const bool xcd_ok = (G == 256);
            const int xcd = xcd_ok ? (bx & 7) : 0, jw = xcd_ok ? ((bx >> 3) * 8 + wave) : gw, jstride = xcd_ok ? 256 : NGW;
            const int nA = xcd_ok ? 576 : 4608, nB = nA, nC = xcd_ok ? 384 : 3072;
            unsigned* qctr = (unsigned*)(a.ws + WS_CTR) + (l * 8 + xcd) * 64;
            for (int li = jw; li < nA + nB + nC; ) {
                unsigned nv = 0u;
                if (xcd_ok && lane == 0) nv = __hip_atomic_fetch_add(qctr, 1u, __ATOMIC_RELAXED, __HIP_MEMORY_SCOPE_AGENT);
                att::TaskP P;
                if (li < nA) {
                    const int task = xcd * nA + li;
                    const int h = task % 6, rr = task / 6;
                    int tokbase, r, rows;
                    if (rr < 256) { tokbase = (rr >> 6) * 4096; r = rr & 63; rows = 64; } else { const int r2 = rr - 256; tokbase = NTOK_P + (r2 >> 5) * 2048; r = r2 & 31; rows = 32; }
                    int r0 = r - 4; r0 = r0 < 0 ? 0 : (r0 > rows - 8 ? rows - 8 : r0);
                    const int qtok0 = tokbase + r * 64, key0 = tokbase + r0 * 64;
                    P.qrow_base = PROJ + ((size_t)h * NTOK + qtok0) * 64; P.grow_base = PROJ + ((size_t)(24 + h) * NTOK + qtok0) * 64;
                    P.kbase = PROJ + ((size_t)(16 + h) * NTOK + key0) * 64; P.ldk = 64;
                    P.vbase = VT + (size_t)(key0 >> 6) * 32768 + (h * 64) * 64; P.ldv = 64; P.vk32 = 0; P.nt = 16;
                    P.minit = -1e30f; P.linit = 0.f; P.rel_row0 = r0 - r + 7; P.tabh = h * 480 + (((r0 >> 1) & 3) << 12); P.dq0 = 0; P.jofs = 0; P.slope = 0.f;
                    att::attn_task<0>(P, tab, wl, lane);
                } else if (li < nA + nB) {
                    const int idx = xcd * nB + (li - nA), h = idx % 6, blk = idx / 6, tok0 = 64 * blk;
                    int tokbase, t0, T;
                    if (tok0 < NTOK_P) { tokbase = tok0 & ~4095; t0 = tok0 & 4095; T = 4096; } else { const int off = tok0 - NTOK_P; tokbase = NTOK_P + (off & ~2047); t0 = off & 2047; T = 2048; }
                    int jlo = 4 - (t0 >> 5); jlo = jlo < 0 ? 0 : jlo;
                    int jhi = ((T - t0) >> 5) + 3; jhi = jhi > 9 ? 9 : jhi;
                    const int sfirst = t0 - 128 + 32 * jlo, kvh = h / 3;
                    P.qrow_base = PROJ + ((size_t)(6 + h) * NTOK + tokbase + t0) * 64; P.grow_base = PROJ + ((size_t)(30 + h) * NTOK + tokbase + t0) * 64;
                    P.kbase = PROJ + ((size_t)(22 + kvh) * NTOK + tokbase + sfirst) * 64; P.ldk = 64;
                    P.vbase = VT + (384 + kvh * 64) * 64; P.ldv = 64; P.vk32 = (tokbase + sfirst) >> 5; P.nt = jhi - jlo + 1;
                    P.minit = a.sink[l * 6 + h] * LOG2E; P.linit = 1.f; P.rel_row0 = 0; P.tabh = 0;
                    P.dq0 = t0 - sfirst; P.jofs = jlo; P.slope = __builtin_amdgcn_exp2f(-8.0f * (float)(h + 1) / 6.0f) * LOG2E;
                    att::attn_task<1>(P, tab, wl, lane);
                } else {
                    const int idx = xcd * nC + (li - nA - nB), h = idx & 3, blk = idx >> 2, tok0 = 64 * blk;
                    const int bg = tok0 < NTOK_P ? (tok0 >> 12) : 4 + ((tok0 - NTOK_P) >> 11);
                    P.qrow_base = PROJ + ((size_t)(12 + h) * NTOK + tok0) * 64; P.grow_base = PROJ + ((size_t)(36 + h) * NTOK + tok0) * 64;
                    P.kbase = MEMK + (size_t)(bg * 256) * 1024 + l * 256 + h * 64; P.ldk = 1024;
                    P.vbase = MEMVT + (size_t)(l * 256 + h * 64) * LDMVT + bg * 256; P.ldv = LDMVT; P.vk32 = 0; P.nt = 8;
                    P.minit = -1e30f; P.linit = 0.f; P.rel_row0 = 0; P.tabh = 0; P.dq0 = 0; P.jofs = 0; P.slope = 0.f;
                    att::attn_task<2>(P, tab, wl, lane);
                }
                li = xcd_ok ? (int)(256u + (unsigned)__builtin_amdgcn_readfirstlane((int)nv)) : li + jstride;
            }
        }
        xcd_barrier(xbar, wave);
        STAMP(2);

        {
            pg8::Gemm g{PROJ, WOUT + (size_t)l * 1024 * 1024, NTOK, 1024, 1024, 64, 1024, PGRP * 2, 128}; pg8::StaticOrder S; S.init(NTOK, 1024, G, bx);
            pg8::EpiOut E{l == 0 ? a.x_prompt : a.out, l == 0 ? a.x_sample - (size_t)NTOK_P * DM : a.out, a.out, XB, ROWSS + (size_t)(l + 1 < DEPTH ? l + 1 : 0) * NTOK, l == DEPTH - 1 ? 1 : 0};
            pg8::gemm_phase<pg8::EpiOut, pg8::StaticOrder>(lds, g, S, E, wave);
        }
#ifdef PROBE_SEL
        grid.sync();
        STAMP(3);
#else
        if (l + 1 < DEPTH) xcd_barrier(xbar, wave);
#endif
    }
#ifdef PROBE_SEL
    if (bx == 0 && wave == 0 && lane_id() == 0) a.out[(size_t)NTOK_P * DM] += (float)tq[PROBE_SEL] * (0.01f / 50.0f);
#endif
}

extern "C" void kernel_launch(void* const* d_in, const int* in_sizes, int n_in, void* d_out, int out_size, void* d_ws, size_t ws_size, hipStream_t stream) {
    static int grid = 0;
    if (grid == 0) {
        if (n_in != 13 || ws_size < WS_END) { fprintf(stderr, "kernel_launch: unexpected n_in %d / ws %zu (need %zu)\n", n_in, ws_size, (size_t)WS_END); grid = -1; return; }
        int dev = 0, cus = 0, per_cu = 0;
        hipGetDevice(&dev);
        hipDeviceGetAttribute(&cus, hipDeviceAttributeMultiprocessorCount, dev);
        if (hipFuncSetAttribute((const void*)hymba_fwd, hipFuncAttributeMaxDynamicSharedMemorySize, LDS_BYTES) != hipSuccess) { fprintf(stderr, "kernel_launch: hipFuncSetAttribute failed\n"); grid = -1; return; }
        if (hipOccupancyMaxActiveBlocksPerMultiprocessor(&per_cu, (const void*)hymba_fwd, 512, LDS_BYTES) != hipSuccess || per_cu < 1) { fprintf(stderr, "kernel_launch: occupancy query failed (%d)\n", per_cu); (void)hipGetLastError(); per_cu = 1; }
        grid = cus * per_cu;
        fprintf(stderr, "kernel_launch: cus %d per_cu %d grid %d\n", cus, per_cu, grid);
    }
    if (grid < 0) return;
    Args a{};
    a.x_prompt = (const float*)d_in[0]; a.x_sample = (const float*)d_in[1]; a.mem_prompt = (const float*)d_in[2]; a.mem_sample = (const float*)d_in[3];
    a.norm_g = (const float*)d_in[4]; a.w_in = (const float*)d_in[5]; a.q_norm_g = (const float*)d_in[6]; a.k_norm_g = (const float*)d_in[7];
    a.rpb = (const float*)d_in[8]; a.sink = (const float*)d_in[9]; a.mem_norm_g = (const float*)d_in[10]; a.w_mem_kv = (const float*)d_in[11]; a.w_out = (const float*)d_in[12];
    a.out = (float*)d_out; a.ws = (unsigned char*)d_ws;
    if (hipMemsetAsync((char*)d_ws + WS_BAR, 0, XCD_BAR_WORDS * 4 + 32 * 256, stream) != hipSuccess) { fprintf(stderr, "kernel_launch: memset of the barrier words failed\n"); return; }
    void* args[] = {&a};
    hipError_t e = hipLaunchCooperativeKernel((const void*)hymba_fwd, dim3(grid), dim3(512), args, LDS_BYTES, stream);
    if (e != hipSuccess) fprintf(stderr, "kernel_launch: cooperative launch failed: %s (grid %d)\n", hipGetErrorString(e), grid);
}
```

```cpp
#include <hip/hip_runtime.h>
#include <hip/hip_cooperative_groups.h>
#include <cstdio>
#include <cstdint>
namespace cg = cooperative_groups;

#define LAS __attribute__((address_space(3)))
#define GAS __attribute__((address_space(1)))
#define DI __device__ __forceinline__
typedef unsigned short bf16_t;
typedef short bf16x8 __attribute__((ext_vector_type(8)));
typedef float f32x2 __attribute__((ext_vector_type(2)));
typedef float f32x4 __attribute__((ext_vector_type(4)));
typedef float f32x16 __attribute__((ext_vector_type(16)));
typedef unsigned u32x2 __attribute__((ext_vector_type(2)));
typedef unsigned u32x4 __attribute__((ext_vector_type(4)));
typedef __bf16 bf16x2_t __attribute__((ext_vector_type(2)));

DI int lane_id() { int x; asm volatile("v_mbcnt_lo_u32_b32 %0, -1, 0\n\tv_mbcnt_hi_u32_b32 %0, -1, %0" : "=&v"(x)); return x; }
DI unsigned pk2(float a, float b) { f32x2 v = {a, b}; bf16x2_t r = __builtin_convertvector(v, bf16x2_t); return __builtin_bit_cast(unsigned, r); }
DI void half_swap(float& a, float& b) { asm volatile("s_nop 1\n\tv_permlane32_swap_b32 %0, %1" : "+v"(a), "+v"(b)); }
DI float half_max(float x) { float a = x, b = x; half_swap(a, b); return fmaxf(a, b); }
DI float half_sum(float x) { float a = x, b = x; half_swap(a, b); return a + b; }
DI float bflo(unsigned u) { return __builtin_bit_cast(float, u << 16); }
DI float bfhi(unsigned u) { return __builtin_bit_cast(float, u & 0xffff0000u); }

constexpr int DM = 1024, NTOK_P = 16384, NTOK = 49152, DEPTH = 4, NMEMTOK = 5120;
constexpr int QLD = 64;
constexpr size_t PGRP = (size_t)NTOK * 64;
constexpr int LDP = 2560;
constexpr int LDVT = NTOK;
constexpr int LDMVT = NMEMTOK;
constexpr float LOG2E = 1.4426950408889634f;
constexpr float RMS_EPS = 1e-6f;
constexpr size_t MiB = 1u << 20;
constexpr size_t WS_ROWSS = 0, WS_MEMSS = 819200, WS_WIN = 1 * MiB, WS_WOUT = 25 * MiB, WS_WMK = 33 * MiB, WS_WMV = 35 * MiB, WS_MEMB = 37 * MiB,
                 WS_MEMK = 47 * MiB, WS_MEMVT = 57 * MiB, WS_XB = 68 * MiB, WS_PROJ = 164 * MiB, WS_VT = 404 * MiB, WS_END = 452 * MiB;
constexpr int LDS_BYTES = 147456;

namespace pg8 {
constexpr int BM = 256, BK = 64, HALF = 128, HTB = HALF * BK * 2, STAGE_BYTES = 8 * HTB, NXCD = 8, WGM = 8;
__host__ __device__ __forceinline__ int lds_byte(int r, int c) { const int st = (r >> 4) * 2 + (c >> 5), rr = r & 15, cc = c & 31, ob = rr * 64 + cc * 2; return st * 1024 + (ob ^ (((ob >> 9) & 1) << 5)); }
__host__ __device__ __forceinline__ void stage_rc(int b, int& R, int& C) { const int st = b / 1024, sb = b % 1024, swz = sb ^ (((sb >> 9) & 1) << 5); R = (st >> 1) * 16 + swz / 64; C = (st & 1) * 32 + (swz % 64) / 2; }
__host__ __device__ __forceinline__ int perm32(int rho) { const int n = rho >> 4, i = rho & 15; return 8 * (i >> 2) + 4 * n + (i & 3); }

struct Unit { int pm, pn; };
struct Gemm { const bf16_t* A; const bf16_t* Bt; int M, N, K, lda, ldb; size_t ksA, ksB; };

struct StaticOrder {
    int nM, nN, nwg, G, c;
    __device__ void init(int M, int N, int G_, int c_) { nM = M / BM; nN = N / BM; nwg = nM * nN; G = G_; c = c_; }
    __device__ bool next(int i, Unit& u) const {
        const long L = (long)i * G + c; if (L >= nwg) return false;
        int wgid = (int)L; { const int q = nwg / NXCD, r = nwg % NXCD, xcd = wgid % NXCD, off = wgid / NXCD; wgid = (xcd < r ? xcd * (q + 1) : r * (q + 1) + (xcd - r) * q) + off; }
        const int nig = WGM * nN, gid = wgid / nig, fm = gid * WGM, gsz = (nM - fm) < WGM ? (nM - fm) : WGM;
        u.pm = fm + ((wgid % nig) % gsz); u.pn = (wgid % nig) / gsz; return true;
    }
};

template <class Epi, class Sched>
DI void gemm_phase(LAS unsigned char* lds, const Gemm g, const Sched& S, const Epi& E, int wave_) {
    int tid_ = wave_ * 64 + lane_id(); asm volatile("" : "+v"(tid_));
    const int tid = tid_, wid = __builtin_amdgcn_readfirstlane(tid >> 6), lane = tid & 63, wr = wid >> 2, wc = wid & 3, fr = lane & 15, fq = lane >> 4;
    const int K = g.K, nt = K / BK;
    unsigned voffA[2], voffB[2];
#pragma unroll
    for (int i = 0; i < 2; ++i) { int R, C; stage_rc(tid * 16 + i * 8192, R, C); const int Rb = (R & ~31) + perm32(R & 31);
        voffA[i] = (unsigned)(R * g.lda + C) * 2u; voffB[i] = (unsigned)(Rb * g.ldb + C) * 2u; }
    const size_t kstepA = g.ksA, kstepB = g.ksB;
    const size_t hstepA = (size_t)HALF * g.lda * 2, tstepA = 2 * hstepA, hstepB = (size_t)HALF * g.ldb * 2, tstepB = 2 * hstepB;
    const unsigned ldsw = (unsigned)wid * 1024u;
    const int aoff = lds_byte(wr * 64 + fr, fq * 8), boff = lds_byte(wc * 32 + fr, fq * 8);
#define PG8_SA(b, h) (((b) * 2 + (h)) * HTB)
#define PG8_SB(b, h) ((4 + (b) * 2 + (h)) * HTB)
#define PG8_STAGE(bufoff, gbase, voff) do { _Pragma("unroll") for (int _i = 0; _i < 2; ++_i) \
        __builtin_amdgcn_global_load_lds((const unsigned*)((const char*)(gbase) + (voff)[_i]), (LAS unsigned*)(lds + (bufoff) + ldsw + _i * 8192), 16, 0, 0); } while (0)
#define PG8_LDA(dst, b, h) do { _Pragma("unroll") for (int m = 0; m < 4; ++m) _Pragma("unroll") for (int k = 0; k < 2; ++k) dst[m][k] = *(const LAS bf16x8*)(lds + PG8_SA(b, h) + aoff + m * 2048 + k * 1024); } while (0)
#define PG8_LDB(dst, b, h) do { _Pragma("unroll") for (int n = 0; n < 2; ++n) _Pragma("unroll") for (int k = 0; k < 2; ++k) dst[n][k] = *(const LAS bf16x8*)(lds + PG8_SB(b, h) + boff + n * 2048 + k * 1024); } while (0)
#define PG8_MMA(ai, bj, At, Bt) do { __builtin_amdgcn_s_setprio(1); _Pragma("unroll") for (int m = 0; m < 4; ++m) _Pragma("unroll") for (int n = 0; n < 2; ++n) _Pragma("unroll") for (int k = 0; k < 2; ++k) \
        acc[ai][bj][m][n] = __builtin_amdgcn_mfma_f32_16x16x32_bf16(Bt[n][k], At[m][k], acc[ai][bj][m][n], 0, 0, 0); __builtin_amdgcn_s_setprio(0); } while (0)
#define PG8_WAIT_V(n) asm volatile("s_waitcnt vmcnt(" #n ")" ::: "memory")
#define PG8_WAIT_L(n) asm volatile("s_waitcnt lgkmcnt(" #n ")" ::: "memory")
#define PG8_BAR __builtin_amdgcn_s_barrier()
#define PG8_SCHED __builtin_amdgcn_sched_barrier(0)
    Unit cur, nxt; int ui = 0;
    if (!S.next(0, cur)) return;
    f32x4 acc[2][2][4][2];
#pragma unroll
    for (int a = 0; a < 2; ++a)
#pragma unroll
        for (int b = 0; b < 2; ++b)
#pragma unroll
            for (int m = 0; m < 4; ++m)
#pragma unroll
                for (int n = 0; n < 2; ++n) acc[a][b][m][n] = (f32x4){0.f, 0.f, 0.f, 0.f};
    bf16x8 At[4][2], B0[2][2], B1[2][2];
    const char* cA = (const char*)g.A + (size_t)cur.pm * tstepA; const char* cB = (const char*)g.Bt + (size_t)cur.pn * tstepB;
    PG8_STAGE(PG8_SB(0, 0), cB, voffB); PG8_STAGE(PG8_SB(0, 1), cB + hstepB, voffB); PG8_STAGE(PG8_SA(0, 0), cA, voffA); PG8_STAGE(PG8_SA(0, 1), cA + hstepA, voffA);
    if (wr == 1) PG8_BAR;
    PG8_WAIT_V(2); PG8_BAR;
    PG8_STAGE(PG8_SB(1, 0), cB + kstepB, voffB); PG8_STAGE(PG8_SA(1, 0), cA + kstepA, voffA); PG8_STAGE(PG8_SB(1, 1), cB + hstepB + kstepB, voffB);
    PG8_WAIT_V(6); PG8_BAR;
    for (;;) {
        const bool has_next = S.next(ui + 1, nxt);
        const char* nA = has_next ? (const char*)g.A + (size_t)nxt.pm * tstepA : cA; const char* nB = has_next ? (const char*)g.Bt + (size_t)nxt.pn * tstepB : cB;
        for (int t = 0; t < nt; t += 2) {
            const bool last = (t == nt - 2);
            const char* a1 = cA + (size_t)(t + 1) * kstepA;
            const char* a2 = last ? nA : cA + (size_t)(t + 2) * kstepA; const char* b2 = last ? nB : cB + (size_t)(t + 2) * kstepB;
            const char* a3 = a2 + kstepA; const char* b3 = b2 + kstepB;
            PG8_LDB(B0, 0, 0); PG8_LDB(B1, 0, 1); PG8_SCHED; PG8_LDA(At, 0, 0); PG8_STAGE(PG8_SA(1, 1), a1 + hstepA, voffA);
            PG8_WAIT_V(8); PG8_WAIT_L(0); PG8_BAR; PG8_MMA(0, 0, At, B0); PG8_MMA(0, 1, At, B1); PG8_BAR; PG8_SCHED;
            PG8_LDA(At, 0, 1); PG8_STAGE(PG8_SB(0, 0), b2, voffB); PG8_STAGE(PG8_SB(0, 1), b2 + hstepB, voffB); PG8_STAGE(PG8_SA(0, 0), a2, voffA);
            PG8_WAIT_V(8); PG8_WAIT_L(0); PG8_BAR; PG8_MMA(1, 0, At, B0); PG8_MMA(1, 1, At, B1); PG8_BAR; PG8_SCHED;
            PG8_LDB(B0, 1, 0); PG8_LDB(B1, 1, 1); PG8_SCHED; PG8_LDA(At, 1, 0); PG8_STAGE(PG8_SA(0, 1), a2 + hstepA, voffA);
            PG8_WAIT_V(8); PG8_WAIT_L(0); PG8_BAR; PG8_MMA(0, 0, At, B0); PG8_MMA(0, 1, At, B1); PG8_BAR; PG8_SCHED;
            PG8_LDA(At, 1, 1); PG8_STAGE(PG8_SB(1, 0), b3, voffB); PG8_STAGE(PG8_SB(1, 1), b3 + hstepB, voffB); PG8_STAGE(PG8_SA(1, 0), a3, voffA);
            PG8_WAIT_V(8); PG8_WAIT_L(0); PG8_BAR; PG8_MMA(1, 0, At, B0); PG8_MMA(1, 1, At, B1); PG8_BAR; PG8_SCHED;
        }
        if (wr == 0) PG8_BAR;
        E(acc, cur, wr, wc, fr, fq);
        if (!has_next) break;
#pragma unroll
        for (int a = 0; a < 2; ++a)
#pragma unroll
            for (int b = 0; b < 2; ++b)
#pragma unroll
                for (int m = 0; m < 4; ++m)
#pragma unroll
                    for (int n = 0; n < 2; ++n) acc[a][b][m][n] = (f32x4){0.f, 0.f, 0.f, 0.f};
        cur = nxt; cA = nA; cB = nB; ++ui;
        if (wr == 1) PG8_BAR;
    }
    PG8_WAIT_V(0);
    PG8_BAR;
#undef PG8_SA
#undef PG8_SB
#undef PG8_STAGE
#undef PG8_LDA
#undef PG8_LDB
#undef PG8_MMA
#undef PG8_WAIT_V
#undef PG8_WAIT_L
#undef PG8_BAR
#undef PG8_SCHED
}

struct EpiRow {
    bf16_t* O; int ldc; const float* rowss; const float* qg; const float* kg; int mode; int blocked;
    DI void operator()(const f32x4 (&acc)[2][2][4][2], const Unit& u, int wr, int wc, int fr, int fq) const {
        const int row0 = u.pm * BM + wr * 64 + fr, col0 = u.pn * BM + 64 * wc + 8 * fq;
        int type; const float* gam = kg; float gsc = 1.f;
        if (mode == 1) { type = 1; gam = kg + u.pn * 192 + 128; }
        else if (u.pn < 4) { type = 0; const int hd = 4 * u.pn + wc; gam = qg + (hd < 6 ? 0 : (hd < 12 ? 64 : 128)); gsc = 0.125f * LOG2E; }
        else if (u.pn < 6) { type = 1; const int hd = 4 * (u.pn - 4) + wc; gam = kg + (hd < 6 ? 0 : 64); }
        else type = 2;
        f32x4 gv[2][2];
#pragma unroll
        for (int bj = 0; bj < 2; ++bj)
#pragma unroll
            for (int n = 0; n < 2; ++n) gv[bj][n] = (type < 2) ? *(const f32x4*)(gam + 32 * bj + 8 * fq + 4 * n) * gsc : (f32x4){1.f, 1.f, 1.f, 1.f};
        float rsv[2][4];
#pragma unroll
        for (int ai = 0; ai < 2; ++ai)
#pragma unroll
            for (int m = 0; m < 4; ++m) rsv[ai][m] = ((const GAS float*)rowss)[row0 + ai * HALF + m * 16];
#pragma unroll
        for (int ai = 0; ai < 2; ++ai)
#pragma unroll
            for (int m = 0; m < 4; ++m) {
                const int row = row0 + ai * HALF + m * 16;
                const float rs = __builtin_amdgcn_rsqf(rsv[ai][m] * (1.0f / 1024.0f) + RMS_EPS);
                f32x4 v[2][2]; float ss = 0.f;
#pragma unroll
                for (int bj = 0; bj < 2; ++bj)
#pragma unroll
                    for (int n = 0; n < 2; ++n) { v[bj][n] = acc[ai][bj][m][n] * rs; const f32x4 x = v[bj][n]; ss += (x[0] * x[0] + x[1] * x[1]) + (x[2] * x[2] + x[3] * x[3]); }
                if (type < 2) {
                    ss += __shfl_xor(ss, 16); ss = half_sum(ss);
                    const float rn = __builtin_amdgcn_rsqf(ss * (1.0f / 64.0f) + RMS_EPS);
#pragma unroll
                    for (int bj = 0; bj < 2; ++bj)
#pragma unroll
                        for (int n = 0; n < 2; ++n) v[bj][n] = v[bj][n] * rn * gv[bj][n];
                } else {
#pragma unroll
                    for (int bj = 0; bj < 2; ++bj)
#pragma unroll
                        for (int n = 0; n < 2; ++n)
#pragma unroll
                            for (int j = 0; j < 4; ++j) { const float x = v[bj][n][j]; v[bj][n][j] = x * __builtin_amdgcn_rcpf(1.0f + __builtin_amdgcn_exp2f(-x * LOG2E)); }
                }
                GAS bf16_t* rowp = blocked ? (GAS bf16_t*)O + ((size_t)(4 * u.pn + wc) * NTOK + row) * 64 + 8 * fq : (GAS bf16_t*)O + (size_t)row * ldc + col0;
#pragma unroll
                for (int bj = 0; bj < 2; ++bj) { u32x4 w; w.x = pk2(v[bj][0][0], v[bj][0][1]); w.y = pk2(v[bj][0][2], v[bj][0][3]); w.z = pk2(v[bj][1][0], v[bj][1][1]); w.w = pk2(v[bj][1][2], v[bj][1][3]);
                    *(GAS u32x4*)(rowp + 32 * bj) = w; }
            }
    }
};
struct EpiCol {
    bf16_t* O; int ldc; const float* colss; int blocked;
    DI void operator()(const f32x4 (&acc)[2][2][4][2], const Unit& u, int wr, int wc, int fr, int fq) const {
        const int row0 = u.pm * BM + wr * 64 + fr, col0 = u.pn * BM + 32 * wc + 8 * fq;
        f32x4 rs[2][2];
#pragma unroll
        for (int bj = 0; bj < 2; ++bj)
#pragma unroll
            for (int n = 0; n < 2; ++n) { const f32x4 s = *(const GAS f32x4*)((const GAS float*)colss + col0 + HALF * bj + 4 * n);
#pragma unroll
                for (int j = 0; j < 4; ++j) rs[bj][n][j] = __builtin_amdgcn_rsqf(s[j] * (1.0f / 1024.0f) + RMS_EPS); }
#pragma unroll
        for (int ai = 0; ai < 2; ++ai)
#pragma unroll
            for (int m = 0; m < 4; ++m) { const int row = row0 + ai * HALF + m * 16;
                GAS bf16_t* rowp = blocked ? (GAS bf16_t*)O + ((size_t)(col0 >> 6) * 512 + row) * 64 + (col0 & 63) : (GAS bf16_t*)O + (size_t)row * ldc + col0;
                const size_t bjstep = blocked ? (size_t)2 * 32768 : (size_t)HALF;
#pragma unroll
                for (int bj = 0; bj < 2; ++bj) { const f32x4 v0 = acc[ai][bj][m][0] * rs[bj][0], v1 = acc[ai][bj][m][1] * rs[bj][1];
                    u32x4 w; w.x = pk2(v0[0], v0[1]); w.y = pk2(v0[2], v0[3]); w.z = pk2(v1[0], v1[1]); w.w = pk2(v1[2], v1[3]);
                    *(GAS u32x4*)(rowp + bjstep * bj) = w; } }
    }
};
struct EpiOut {
    const float* xin_p; const float* xin_s; float* out; bf16_t* xb; float* ss_next; int last;
    DI void operator()(const f32x4 (&acc)[2][2][4][2], const Unit& u, int wr, int wc, int fr, int fq) const {
        const int row0 = u.pm * BM + wr * 64 + fr, col0 = u.pn * BM + 32 * wc + 8 * fq;
        const GAS float* xin = (const GAS float*)((u.pm < NTOK_P / BM) ? xin_p : xin_s);
        GAS float* outg = (GAS float*)out; GAS bf16_t* xbg = (GAS bf16_t*)xb;
#pragma unroll
        for (int ai = 0; ai < 2; ++ai) {
            f32x4 xv[4][2][2];
#pragma unroll
            for (int m = 0; m < 4; ++m) { const size_t off = (size_t)(row0 + ai * HALF + m * 16) * DM + col0;
#pragma unroll
                for (int bj = 0; bj < 2; ++bj)
#pragma unroll
                    for (int n = 0; n < 2; ++n) xv[m][bj][n] = *(const GAS f32x4*)(xin + off + HALF * bj + 4 * n); }
#pragma unroll
            for (int m = 0; m < 4; ++m) { const int row = row0 + ai * HALF + m * 16; const size_t off = (size_t)row * DM + col0; float ss = 0.f;
#pragma unroll
                for (int bj = 0; bj < 2; ++bj) { f32x4 v[2];
#pragma unroll
                    for (int n = 0; n < 2; ++n) { v[n] = xv[m][bj][n] + acc[ai][bj][m][n]; __builtin_nontemporal_store(v[n], (GAS f32x4*)(outg + off + HALF * bj + 4 * n));
                        ss += (v[n][0] * v[n][0] + v[n][1] * v[n][1]) + (v[n][2] * v[n][2] + v[n][3] * v[n][3]); }
                    if (!last) { u32x4 w; w.x = pk2(v[0][0], v[0][1]); w.y = pk2(v[0][2], v[0][3]); w.z = pk2(v[1][0], v[1][1]); w.w = pk2(v[1][2], v[1][3]); *(GAS u32x4*)(xbg + off + HALF * bj) = w; } }
                if (!last) { ss += __shfl_xor(ss, 16); ss = half_sum(ss); if (fq == 0) atomicAdd(ss_next + row, ss); } }
        }
    }
};
}

namespace att {
#define MFMA32(a, b, c) __builtin_amdgcn_mfma_f32_32x32x16_bf16((a), (b), (c), 0, 0, 0)
constexpr int TAB_OFF = 131072;
struct TaskP {
    bf16_t* qrow_base;
    const bf16_t* grow_base;
    const bf16_t* kbase;
    const bf16_t* vbase;
    int ldk, ldv, nt;
    float minit, linit;
    int rel_row0, tabh;
    int vk32;
    int dq0, jofs; float slope;
};
template <int KIND>
DI void attn_task(const TaskP& P, const LAS float* tab, LAS unsigned char* wl, int lane) {
    const int q = lane & 31, hh = lane >> 5;
    const int pil = (q & 0x13) | ((q & 4) << 1) | ((q & 8) >> 1);
    GAS bf16_t* qrow = (GAS bf16_t*)P.qrow_base + q * QLD;
    bf16x8 qf[2][4];
#pragma unroll
    for (int u = 0; u < 2; ++u)
#pragma unroll
        for (int ks = 0; ks < 4; ++ks) qf[u][ks] = *(const GAS bf16x8*)(qrow + (32 * u) * QLD + 32 * hh + 8 * ks);
    f32x16 oa[2], ob[2];
#pragma unroll
    for (int u = 0; u < 2; ++u)
#pragma unroll
        for (int i = 0; i < 16; ++i) { oa[u][i] = 0.f; ob[u][i] = 0.f; }
    float mrun[2], lrun[2];
    mrun[0] = mrun[1] = P.minit; lrun[0] = lrun[1] = (hh == 0) ? P.linit : 0.f;
    const int l3 = lane >> 3, l4 = lane >> 4;
    const int vc = (lane & 3) ^ (l4 & 3);
    const GAS bf16_t* kg = (const GAS bf16_t*)P.kbase;
    const GAS bf16_t* vg0 = (const GAS bf16_t*)P.vbase;
    const unsigned kro0 = (unsigned)(pil * 128 + (((4 * hh) ^ ((pil >> 1) & 7)) * 16));
    const unsigned vro0 = (unsigned)(4096 + pil * 64 + ((hh ^ ((pil >> 2) & 3)) * 16));
    const int kca = (lane & 7) ^ (l4 & 7);
    const unsigned kof0 = (unsigned)(l3 * P.ldk + 8 * kca) * 2u;
    const unsigned vof0 = (unsigned)((lane >> 2) * P.ldv + ((KIND == 0) ? ((vc >> 1) * 32768 + 8 * (vc & 1)) : (8 * vc))) * 2u;
#define ATT_RP(t_) ((((t_) >> 2) - (P.tabh >> 12)) & 3)
#define ATT_TILEKEY(t_) ((KIND == 0) ? (128 * ATT_RP(t_) + 16 * ((t_) & 3)) : (32 * (t_)))
#define ATT_KROW(i_) ((KIND == 0) ? (((i_) >> 1) * 64 + 8 * ((i_) & 1)) : (8 * (i_)))
#define ATT_PIECE_K(t_, buf_, i_) do { const GAS char* kt_ = (const GAS char*)(kg + (size_t)(ATT_TILEKEY(t_) + ATT_KROW(i_)) * P.ldk); \
        __builtin_amdgcn_global_load_lds((const GAS unsigned*)(kt_ + (((i_) & 1) ? (kof0 ^ 64u) : kof0)), (LAS unsigned*)(wl + (buf_) * 8192 + (i_) * 1024), 16, 0, 0); } while (0)
#define ATT_TILEKEY_V(t_) ((KIND == 0) ? (65536 * ATT_RP(t_) + 16 * ((t_) & 3)) : (KIND == 1) ? ((((P.vk32 + (t_)) >> 1) * 32768) + ((P.vk32 + (t_)) & 1) * 32) : (32 * (t_)))
#define ATT_PIECE_V(t_, buf_, i_) do { const GAS char* vt_ = (const GAS char*)(vg0 + (size_t)(16 * (i_)) * P.ldv + ATT_TILEKEY_V(t_)); \
        __builtin_amdgcn_global_load_lds((const GAS unsigned*)(vt_ + vof0), (LAS unsigned*)(wl + (buf_) * 8192 + 4096 + (i_) * 1024), 16, 0, 0); } while (0)
#pragma unroll
    for (int i = 0; i < 4; ++i) ATT_PIECE_K(0, 0, i);
#pragma unroll
    for (int i = 0; i < 4; ++i) ATT_PIECE_V(0, 0, i);
    if (P.nt > 1) {
#pragma unroll
        for (int i = 0; i < 4; ++i) ATT_PIECE_K(1, 1, i);
    }
    for (int t = 0; t < P.nt; ++t) {
        asm volatile("" ::: "memory");
        if (t + 1 < P.nt) asm volatile("s_waitcnt vmcnt(8)" ::: "memory"); else asm volatile("s_waitcnt vmcnt(4)" ::: "memory");
        const LAS unsigned char* bb = wl + (t & 1) * 8192;
        const bool moreK = (t + 2 < P.nt), moreV = (t + 1 < P.nt);
        bool act[2];
#pragma unroll
        for (int u = 0; u < 2; ++u) { act[u] = true;
            if (KIND == 0) { const int cb = t & 3; act[u] = !(cb < u || cb > u + 2); }
            if (KIND == 1) { const int j = P.jofs + t; act[u] = !(j < u || j > u + 8); } }
        f32x16 sv[2];
        {
            bf16x8 kf[4];
#pragma unroll
            for (int ks = 0; ks < 4; ++ks) kf[ks] = *(const LAS bf16x8*)(bb + (kro0 ^ (16u * ks)));
#pragma unroll
            for (int u = 0; u < 2; ++u) {
#pragma unroll
                for (int i = 0; i < 16; ++i) sv[u][i] = 0.f;
                if (act[u]) {
                    __builtin_amdgcn_s_setprio(1);
#pragma unroll
                    for (int ks = 0; ks < 4; ++ks) sv[u] = MFMA32(kf[ks], qf[u][ks], sv[u]);
                    __builtin_amdgcn_s_setprio(0);
                }
            }
        }
        asm volatile("s_waitcnt lgkmcnt(0)" ::: "memory");
        bf16x8 pb[2][2];
#pragma unroll
        for (int u = 0; u < 2; ++u) {
            f32x16 s = sv[u];
            float mn = 0.f;
            if (act[u]) {
                if (KIND == 0) {
                    const int rp = ATT_RP(t), cb = t & 3;
                    const int qc = 32 * u + q;
                    const int cs = qc - 8 < 0 ? 0 : (qc - 8 > 48 ? 48 : qc - 8);
                    const int kcb = 16 * cb + 8 * hh;
                    const int db = kcb - qc + 15, mb = kcb - cs;
                    const LAS float* tr0 = tab + ((P.tabh & 4095) + (P.rel_row0 + 2 * rp) * 32 + db);
                    const unsigned taddr = (unsigned)(size_t)tr0;
#pragma unroll
                    for (int hb = 0; hb < 2; ++hb) {
                        float bz[8]; const unsigned ta2 = taddr + 128u * hb;
                        asm volatile("ds_read_b32 %0, %8\n\tds_read_b32 %1, %8 offset:4\n\tds_read_b32 %2, %8 offset:8\n\tds_read_b32 %3, %8 offset:12\n\t"
                                     "ds_read_b32 %4, %8 offset:16\n\tds_read_b32 %5, %8 offset:20\n\tds_read_b32 %6, %8 offset:24\n\tds_read_b32 %7, %8 offset:28\n\t"
                                     "s_waitcnt lgkmcnt(0)"
                                     : "=&v"(bz[0]), "=&v"(bz[1]), "=&v"(bz[2]), "=&v"(bz[3]), "=&v"(bz[4]), "=&v"(bz[5]), "=&v"(bz[6]), "=&v"(bz[7])
                                     : "v"(ta2) : "memory");
#pragma unroll
                        for (int ci = 0; ci < 8; ++ci) { const bool valid = (unsigned)(mb + ci) < 16u;
                            s[8 * hb + ci] = valid ? s[8 * hb + ci] + bz[ci] : -INFINITY; }
                    }
                } else if (KIND == 1) {
                    const float fdq = (float)(P.dq0 + 32 * u + q - 8 * hh - 32 * t);
                    const int jrel = P.jofs + t - u;
                    if (jrel >= 1 && jrel <= 7) {
#pragma unroll
                        for (int i = 0; i < 16; ++i) { const float ci = (float)((i & 7) + 16 * (i >> 3)); s[i] = s[i] - P.slope * fabsf(fdq - ci); }
                    } else {
#pragma unroll
                        for (int i = 0; i < 16; ++i) { const float ci = (float)((i & 7) + 16 * (i >> 3));
                            const float ad = fabsf(fdq - ci);
                            s[i] = ad <= 128.f ? s[i] - P.slope * ad : -INFINITY; }
                    }
                }
                float mx = fmaxf(s[0], s[1]);
#pragma unroll
                for (int i = 2; i < 16; ++i) mx = fmaxf(mx, s[i]);
                mx = half_max(mx);
                const float mold = mrun[u];
                mn = (mx > mold + 8.f) ? mx : mold;
                if (__builtin_amdgcn_ballot_w64(mn != mold)) {
                    const float alpha = __builtin_amdgcn_exp2f(mold - mn);
                    lrun[u] *= alpha;
#pragma unroll
                    for (int i = 0; i < 16; ++i) { oa[u][i] *= alpha; ob[u][i] *= alpha; }
                    mrun[u] = mn;
                }
            }
            __builtin_amdgcn_sched_barrier(0);
            if (moreK) { ATT_PIECE_K(t + 2, t & 1, 2 * u); ATT_PIECE_K(t + 2, t & 1, 2 * u + 1); }
            __builtin_amdgcn_sched_barrier(0);
            if (act[u]) {
                float ps0 = 0.f, ps1 = 0.f;
#pragma unroll
                for (int i = 0; i < 16; i += 2) { s[i] = __builtin_amdgcn_exp2f(s[i] - mn); s[i + 1] = __builtin_amdgcn_exp2f(s[i + 1] - mn); ps0 += s[i]; ps1 += s[i + 1]; }
                lrun[u] += ps0 + ps1;
#pragma unroll
                for (int sx = 0; sx < 2; ++sx) { u32x4 w; w.x = pk2(s[8 * sx], s[8 * sx + 1]); w.y = pk2(s[8 * sx + 2], s[8 * sx + 3]); w.z = pk2(s[8 * sx + 4], s[8 * sx + 5]); w.w = pk2(s[8 * sx + 6], s[8 * sx + 7]);
                    pb[u][sx] = __builtin_bit_cast(bf16x8, w); }
            }
            __builtin_amdgcn_sched_barrier(0);
            if (moreV) { ATT_PIECE_V(t + 1, (t + 1) & 1, 2 * u); ATT_PIECE_V(t + 1, (t + 1) & 1, 2 * u + 1); }
            __builtin_amdgcn_sched_barrier(0);
        }
        if (moreK) asm volatile("s_waitcnt vmcnt(8)" ::: "memory");
        else if (moreV) asm volatile("s_waitcnt vmcnt(4)" ::: "memory");
        else asm volatile("s_waitcnt vmcnt(0)" ::: "memory");
        {
            bf16x8 vf[4];
            vf[0] = *(const LAS bf16x8*)(bb + vro0); vf[1] = *(const LAS bf16x8*)(bb + (vro0 ^ 32u));
            vf[2] = *(const LAS bf16x8*)(bb + vro0 + 2048); vf[3] = *(const LAS bf16x8*)(bb + (vro0 ^ 32u) + 2048);
#pragma unroll
            for (int u = 0; u < 2; ++u) {
                if (!act[u]) continue;
                __builtin_amdgcn_s_setprio(1);
                oa[u] = MFMA32(vf[0], pb[u][0], oa[u]); oa[u] = MFMA32(vf[1], pb[u][1], oa[u]);
                ob[u] = MFMA32(vf[2], pb[u][0], ob[u]); ob[u] = MFMA32(vf[3], pb[u][1], ob[u]);
                __builtin_amdgcn_s_setprio(0);
            }
        }
        asm volatile("s_waitcnt lgkmcnt(0)" ::: "memory");
    }
#undef ATT_PIECE_K
#undef ATT_TILEKEY
#undef ATT_RP
#undef ATT_TILEKEY_V
#undef ATT_KROW
#undef ATT_PIECE_V
    u32x4 gtv[2][4];
#pragma unroll
    for (int u = 0; u < 2; ++u) { const GAS bf16_t* grow = (const GAS bf16_t*)P.grow_base + (32 * u + q) * QLD + 8 * hh;
#pragma unroll
        for (int c = 0; c < 4; ++c) gtv[u][c] = *(const GAS u32x4*)(grow + 16 * c); }
#pragma unroll
    for (int u = 0; u < 2; ++u) {
        const float lt = half_sum(lrun[u]);
        const float inv = __builtin_amdgcn_rcpf(lt);
        GAS bf16_t* orow = qrow + (32 * u) * QLD;
#pragma unroll
        for (int db = 0; db < 2; ++db)
#pragma unroll
            for (int g = 0; g < 2; ++g) { const int d0 = 32 * db + 16 * g + 8 * hh;
                const u32x4 gt = gtv[u][2 * db + g];
                float ov[8];
#pragma unroll
                for (int j = 0; j < 8; ++j) ov[j] = (db == 0 ? oa[u][8 * g + j] : ob[u][8 * g + j]) * inv;
                u32x4 w; w.x = pk2(ov[0] * bflo(gt.x), ov[1] * bfhi(gt.x)); w.y = pk2(ov[2] * bflo(gt.y), ov[3] * bfhi(gt.y));
                w.z = pk2(ov[4] * bflo(gt.z), ov[5] * bfhi(gt.z)); w.w = pk2(ov[6] * bflo(gt.w), ov[7] * bfhi(gt.w));
                *(GAS u32x4*)(orow + d0) = w; }
    }
}
}


#define XB_TMO      128
#define XB_XCNT(j)  (256  + 64 * (j))
#define XB_XSUB(j)  (1280 + 64 * (j))
#define XB_XGEN(j)  (2304 + 64 * (j))
#define XB_TOP      3328
#define XB_TOPGEN   3392
#define XCD_BAR_WORDS 3456
#define XB_SPIN_CAP (1u << 22)
DI unsigned xb_ld(unsigned* p)              { return __hip_atomic_load(p, __ATOMIC_RELAXED, __HIP_MEMORY_SCOPE_AGENT); }
DI unsigned xb_add(unsigned* p, unsigned v) { return __hip_atomic_fetch_add(p, v, __ATOMIC_RELAXED, __HIP_MEMORY_SCOPE_AGENT); }
DI unsigned xb_xcc_id() { return (unsigned)__builtin_amdgcn_s_getreg((3 << 11) | 20) & 0xFu; }
#define XB_SPIN(cond, bar) do { unsigned _sp = 0; while (cond) { __builtin_amdgcn_s_sleep(1); \
    if ((++_sp & 255u) == 0u) { if (xb_ld(&(bar)[XB_TMO])) break; if (_sp > XB_SPIN_CAP) { atomicAdd(&(bar)[XB_TMO], 1u); break; } } } } while (0)
struct XcdBarrier { unsigned* bar; unsigned x; volatile LAS unsigned* st; };
DI XcdBarrier xcd_barrier_post(unsigned* bar, volatile LAS unsigned* st, bool t0) {
    XcdBarrier b; b.bar = bar; b.x = xb_xcc_id(); b.st = st;
    if (t0) (void)xb_add(&bar[XB_XCNT(b.x)], 1u);
    return b;
}
DI void xcd_barrier_complete(unsigned* bar, unsigned x, unsigned& nloc, unsigned& nx) {
    const unsigned G = gridDim.x * gridDim.y * gridDim.z;
    unsigned sum, cnt, mine, sp = 0u;
    for (;;) {
        sum = 0u; cnt = 0u; mine = 0u;
#pragma unroll
        for (unsigned j = 0; j < 16; ++j) { const unsigned c = xb_ld(&bar[XB_XCNT(j)]); sum += c; cnt += (c > 0u) ? 1u : 0u; mine = (j == x) ? c : mine; }
        if (sum == G) break;
        __builtin_amdgcn_s_sleep(1);
        if ((++sp & 255u) == 0u) { if (xb_ld(&bar[XB_TMO])) break; if (sp > XB_SPIN_CAP) { atomicAdd(&bar[XB_TMO], 1u); break; } }
    }
    nloc = mine > 0u ? mine : 1u; nx = cnt > 0u ? cnt : 1u;
}
DI void xcd_barrier(const XcdBarrier& b, int wave_) {
    const bool t0 = (wave_ == 0) && (lane_id() == 0);
    asm volatile("s_waitcnt vmcnt(0)" ::: "memory");
    __syncthreads();
    if (t0) {
        unsigned* bar = b.bar;
        __builtin_amdgcn_s_waitcnt(0);
        unsigned nloc = b.st[0], nx = b.st[1];
        if (nloc == 0u) { xcd_barrier_complete(bar, b.x, nloc, nx); b.st[0] = nloc; b.st[1] = nx; }
        const unsigned old = xb_add(&bar[XB_XSUB(b.x)], 1u);
        const unsigned gen = old / nloc;
        if (old + 1u == (gen + 1u) * nloc) {
            __builtin_amdgcn_fence(__ATOMIC_RELEASE, "agent");
            asm volatile("s_waitcnt vmcnt(0)" ::: "memory");
            const unsigned og = xb_add(&bar[XB_TOP], 1u);
            const unsigned tg = og / nx;
            if (og + 1u == (tg + 1u) * nx) xb_add(&bar[XB_TOPGEN], 1u);
            else XB_SPIN(xb_ld(&bar[XB_TOPGEN]) == tg, bar);
            __builtin_amdgcn_fence(__ATOMIC_ACQUIRE, "agent");
            xb_add(&bar[XB_XGEN(b.x)], 1u);
            asm volatile("s_waitcnt vmcnt(0)" ::: "memory");
        } else {
            XB_SPIN(xb_ld(&bar[XB_XGEN(b.x)]) == gen, bar);
            __builtin_amdgcn_fence(__ATOMIC_ACQUIRE, "agent");
            asm volatile("s_waitcnt vmcnt(0)" ::: "memory");
        }
    }
    __syncthreads();
}
constexpr size_t WS_BAR = 901120;
constexpr size_t WS_CTR = WS_BAR + 13824;
constexpr int LDS_BARST = 143360;

struct Args {
    const float *x_prompt, *x_sample, *mem_prompt, *mem_sample, *norm_g, *w_in, *q_norm_g, *k_norm_g, *rpb, *sink, *mem_norm_g, *w_mem_kv, *w_out;
    float* out; unsigned char* ws;
};
#define LDS_WAIT() asm volatile("s_waitcnt lgkmcnt(0)" ::: "memory")
DI float wave_sum(float v) {
#pragma unroll
    for (int o = 1; o < 64; o <<= 1) v += __shfl_xor(v, o);
    return v;
}
DI void p0_transpose_item(const float* W, int ldw, int srccol0, bf16_t* WT, int dstrow0, const float* g, LAS float* scr, int kb, int lane) {
    const int k0 = 64 * kb;
    float wv[32];
    const GAS float* Wg = (const GAS float*)W + (size_t)(k0 + (lane >> 5)) * ldw + srccol0 + (lane & 31);
#pragma unroll
    for (int i = 0; i < 32; ++i) wv[i] = Wg[(size_t)(2 * i) * ldw];
    const float g0 = g ? ((const GAS float*)g)[k0 + (lane & 63)] : 1.f;
#pragma unroll
    for (int i = 0; i < 32; ++i) { const int kk = 2 * i + (lane >> 5); const float sc = __shfl(g0, kk); scr[kk * 33 + (lane & 31)] = wv[i] * sc; }
    LDS_WAIT(); asm volatile("" ::: "memory");
    const int c = lane & 7;
#pragma unroll
    for (int j = 0; j < 4; ++j) { const int n = (lane >> 3) + 8 * j; const LAS float* s = scr + (8 * c) * 33 + n;
        u32x4 o; o.x = pk2(s[0 * 33], s[1 * 33]); o.y = pk2(s[2 * 33], s[3 * 33]); o.z = pk2(s[4 * 33], s[5 * 33]); o.w = pk2(s[6 * 33], s[7 * 33]);
        *(u32x4*)(WT + (size_t)(dstrow0 + n) * 1024 + k0 + 8 * c) = o; }
    LDS_WAIT(); asm volatile("" ::: "memory");
}
DI void rows4_to_bf16(const float* src, bf16_t* dst, float* ssq, int m0, int st, int lane) {
    f32x4 v[4][4]; float sq[4];
#pragma unroll
    for (int r = 0; r < 4; ++r) { const GAS f32x4* xr = (const GAS f32x4*)(src + (size_t)(m0 + r * st) * DM) + lane;
#pragma unroll
        for (int j = 0; j < 4; ++j) v[r][j] = xr[64 * j]; }
#pragma unroll
    for (int r = 0; r < 4; ++r) { sq[r] = 0.f;
#pragma unroll
        for (int j = 0; j < 4; ++j) sq[r] += (v[r][j].x * v[r][j].x + v[r][j].y * v[r][j].y) + (v[r][j].z * v[r][j].z + v[r][j].w * v[r][j].w);
        sq[r] = wave_sum(sq[r]);
        GAS u32x2* o8 = (GAS u32x2*)(dst + (size_t)(m0 + r * st) * DM) + lane;
#pragma unroll
        for (int j = 0; j < 4; ++j) { u32x2 w; w.x = pk2(v[r][j].x, v[r][j].y); w.y = pk2(v[r][j].z, v[r][j].w); o8[64 * j] = w; }
        if (lane == 0) ((GAS float*)ssq)[m0 + r * st] = sq[r]; }
}
DI int segmap(int c) {
    if (c < 384) return c;
    if (c < 768) return 1536 + (c - 384);
    if (c < 1024) return 2560 + (c - 768);
    if (c < 1408) return 384 + (c - 1024);
    if (c < 1536) return 1920 + (c - 1408);
    if (c < 1920) return 1152 + (c - 1536);
    if (c < 2304) return 2176 + (c - 1920);
    return 2816 + (c - 2304);
}

__global__ void __launch_bounds__(512, 2) hymba_fwd(Args a) {
    extern __shared__ __attribute__((aligned(16))) unsigned char lds_raw[];
    LAS unsigned char* lds = (LAS unsigned char*)lds_raw;
    cg::grid_group grid = cg::this_grid();
    const int wave = __builtin_amdgcn_readfirstlane((int)threadIdx.x >> 6);
    const int lane = lane_id(), tid = wave * 64 + lane;
    const int G = gridDim.x, bx = blockIdx.x;
    const int gw = bx * 8 + wave, NGW = G * 8;
    unsigned char* ws = a.ws;
    float* ROWSS = (float*)(ws + WS_ROWSS); float* MEMSS = (float*)(ws + WS_MEMSS);
    bf16_t* WIN = (bf16_t*)(ws + WS_WIN); bf16_t* WOUT = (bf16_t*)(ws + WS_WOUT); bf16_t* WMK = (bf16_t*)(ws + WS_WMK); bf16_t* WMV = (bf16_t*)(ws + WS_WMV);
    bf16_t* MEMB = (bf16_t*)(ws + WS_MEMB); bf16_t* MEMK = (bf16_t*)(ws + WS_MEMK); bf16_t* MEMVT = (bf16_t*)(ws + WS_MEMVT);
    bf16_t* XB = (bf16_t*)(ws + WS_XB); bf16_t* PROJ = (bf16_t*)(ws + WS_PROJ); bf16_t* VT = (bf16_t*)(ws + WS_VT);

#ifdef PROBE_SEL
    unsigned long long tq[4] = {0, 0, 0, 0}; unsigned long long tlast = __builtin_amdgcn_s_memrealtime();
#define STAMP(k) do { const unsigned long long tnow = __builtin_amdgcn_s_memrealtime(); tq[k] += tnow - tlast; tlast = tnow; } while (0)
#else
#define STAMP(k) do {} while (0)
#endif
    if (tid == 0) { ((volatile LAS unsigned*)(lds + LDS_BARST))[0] = 0u; ((volatile LAS unsigned*)(lds + LDS_BARST))[1] = 0u; }
    __syncthreads();
    const XcdBarrier xbar = xcd_barrier_post((unsigned*)(a.ws + WS_BAR), (volatile LAS unsigned*)(lds + LDS_BARST), tid == 0);
    {
        LAS float* scr = (LAS float*)(lds + wave * 16384);
        constexpr int I_IN = DEPTH * 96 * 16, I_OUT = DEPTH * 32 * 16, I_MK = DEPTH * 8 * 16, I_MV = I_MK, NITEMS = I_IN + I_OUT + I_MK + I_MV;
        for (int it = gw; it < NITEMS; it += NGW) {
            int r = it;
            if (r < I_IN) { const int l = r / 1536, rem = r % 1536, nb = rem >> 4, kb = rem & 15; int src;
                if (nb < 80) { const int R0 = 32 * nb, pn = R0 >> 8, p = R0 & 255, bj = p >> 7, hd = (p >> 5) & 3; src = segmap(256 * pn + 64 * hd + 32 * bj); }
                else { const int vr = 32 * (nb - 80); src = vr < 384 ? 768 + vr : 2048 + (vr - 384); }
                p0_transpose_item(a.w_in + (size_t)l * 1024 * 3072, 3072, src, WIN + (size_t)l * 3072 * 1024, 32 * nb, a.norm_g + l * 1024, scr, kb, lane); continue; }
            r -= I_IN;
            if (r < I_OUT) { const int l = r / 512, rem = r % 512, nb = rem >> 4, kb = rem & 15;
                p0_transpose_item(a.w_out + (size_t)l * 1024 * 1024, 1024, 32 * nb, WOUT + (size_t)l * 1024 * 1024, 32 * nb, nullptr, scr, kb, lane); continue; }
            r -= I_OUT;
            if (r < I_MK) { const int l = r / 128, rem = r % 128, nb = rem >> 4, kb = rem & 15; const int p = 32 * nb, bj = p >> 7, hd = (p >> 5) & 3;
                p0_transpose_item(a.w_mem_kv + (size_t)l * 1024 * 512, 512, 64 * hd + 32 * bj, WMK + (size_t)l * 256 * 1024, 32 * nb, a.mem_norm_g + l * 1024, scr, kb, lane); continue; }
            r -= I_MK;
            { const int l = r / 128, rem = r % 128, nb = rem >> 4, kb = rem & 15;
                p0_transpose_item(a.w_mem_kv + (size_t)l * 1024 * 512, 512, 256 + 32 * nb, WMV + (size_t)l * 256 * 1024, 32 * nb, a.mem_norm_g + l * 1024, scr, kb, lane); }
        }
        for (int m = gw; m < NTOK_P / 4; m += NGW) rows4_to_bf16(a.x_prompt, XB, ROWSS, m, NTOK_P / 4, lane);
        for (int m = gw; m < (NTOK - NTOK_P) / 4; m += NGW) rows4_to_bf16(a.x_sample, XB + (size_t)NTOK_P * DM, ROWSS + NTOK_P, m, (NTOK - NTOK_P) / 4, lane);
        for (int m = gw; m < 1024 / 4; m += NGW) rows4_to_bf16(a.mem_prompt, MEMB, MEMSS, m, 1024 / 4, lane);
        for (int m = gw; m < 4096 / 4; m += NGW) rows4_to_bf16(a.mem_sample, MEMB + (size_t)1024 * DM, MEMSS + 1024, m, 4096 / 4, lane);
        for (int i = bx * 512 + tid; i < 3 * NTOK; i += G * 512) ROWSS[NTOK + i] = 0.f;
    }
    if (a.ws == nullptr) grid.sync();
    xcd_barrier(xbar, wave);
    STAMP(0);

    {
        pg8::Gemm g{MEMB, WMK, NMEMTOK, 1024, 1024, 1024, 1024, 128, 128}; pg8::StaticOrder S; S.init(NMEMTOK, 1024, G, bx);
        pg8::EpiRow E{MEMK, 1024, MEMSS, a.q_norm_g, a.k_norm_g, 1, 0};
        pg8::gemm_phase<pg8::EpiRow, pg8::StaticOrder>(lds, g, S, E, wave);
    }
    {
        pg8::Gemm g{WMV, MEMB, 1024, NMEMTOK, 1024, 1024, 1024, 128, 128}; pg8::StaticOrder S; S.init(1024, NMEMTOK, G, (bx + 176) % G);
        pg8::EpiCol E{MEMVT, LDMVT, MEMSS, 0};
        pg8::gemm_phase<pg8::EpiCol, pg8::StaticOrder>(lds, g, S, E, wave);
    }

#pragma unroll 1
    for (int l = 0; l < DEPTH; ++l) {
        unsigned char* ws = a.ws; asm volatile("" : "+s"(ws));
        float* ROWSS = (float*)(ws + WS_ROWSS);
        bf16_t* WIN = (bf16_t*)(ws + WS_WIN); bf16_t* WOUT = (bf16_t*)(ws + WS_WOUT);
        bf16_t* MEMK = (bf16_t*)(ws + WS_MEMK); bf16_t* MEMVT = (bf16_t*)(ws + WS_MEMVT);
        bf16_t* XB = (bf16_t*)(ws + WS_XB); bf16_t* PROJ = (bf16_t*)(ws + WS_PROJ); bf16_t* VT = (bf16_t*)(ws + WS_VT);
        {
            pg8::Gemm g{XB, WIN + (size_t)l * 3072 * 1024, NTOK, 2560, 1024, 1024, 1024, 128, 128}; pg8::StaticOrder S; S.init(NTOK, 2560, G, bx);
            pg8::EpiRow E{PROJ, LDP, ROWSS + (size_t)l * NTOK, a.q_norm_g + l * 192, a.k_norm_g + l * 192, 0, 1};
            pg8::gemm_phase<pg8::EpiRow, pg8::StaticOrder>(lds, g, S, E, wave);
        }
        {
            pg8::Gemm g{WIN + (size_t)l * 3072 * 1024 + (size_t)2560 * 1024, XB, 512, NTOK, 1024, 1024, 1024, 128, 128}; pg8::StaticOrder S; S.init(512, NTOK, G, (bx + G / 2) % G);
            pg8::EpiCol E{VT, LDVT, ROWSS + (size_t)l * NTOK, 1};
            pg8::gemm_phase<pg8::EpiCol, pg8::StaticOrder>(lds, g, S, E, wave);
        }
        xcd_barrier(xbar, wave);
        STAMP(1);

        {
            int tid2 = wave * 64 + lane_id(); asm volatile("" : "+v"(tid2));
            const int tid = tid2, lane = tid & 63;
            LAS float* tab = (LAS float*)(lds + att::TAB_OFF);
            for (int i = tid; i < 6 * 15 * 32; i += 512) { const int h = i / 480, rem = i % 480, rr = rem >> 5, c = rem & 31;
                tab[i] = c < 31 ? a.rpb[(size_t)((l * 6 + h) * 15 + rr) * 31 + c] * LOG2E : 0.f; }
            __syncthreads();
            LAS unsigned char* wl = lds + wave * 16384;
            const bool xcd_ok = (G == 256);
            const int xcd = xcd_ok ? (bx & 7) : 0, jw = xcd_ok ? ((bx >> 3) * 8 + wave) : gw, jstride = xcd_ok ? 256 : NGW;
            const int nA = xcd_ok ? 576 : 4608, nB = nA, nC = xcd_ok ? 384 : 3072;
            unsigned* qctr = (unsigned*)(a.ws + WS_CTR) + (l * 8 + xcd) * 64;
            for (int li = jw; li < nA + nB + nC; ) {
                unsigned nv = 0u;
                if (xcd_ok && lane == 0) nv = __hip_atomic_fetch_add(qctr, 1u, __ATOMIC_RELAXED, __HIP_MEMORY_SCOPE_AGENT);
                att::TaskP P;
                if (li < nA) {
                    const int task = xcd * nA + li;
                    const int h = task % 6, rr = task / 6;
                    int tokbase, r, rows;
                    if (rr < 256) { tokbase = (rr >> 6) * 4096; r = rr & 63; rows = 64; } else { const int r2 = rr - 256; tokbase = NTOK_P + (r2 >> 5) * 2048; r = r2 & 31; rows = 32; }
                    int r0 = r - 4; r0 = r0 < 0 ? 0 : (r0 > rows - 8 ? rows - 8 : r0);
                    const int qtok0 = tokbase + r * 64, key0 = tokbase + r0 * 64;
                    P.qrow_base = PROJ + ((size_t)h * NTOK + qtok0) * 64; P.grow_base = PROJ + ((size_t)(24 + h) * NTOK + qtok0) * 64;
                    P.kbase = PROJ + ((size_t)(16 + h) * NTOK + key0) * 64; P.ldk = 64;
                    P.vbase = VT + (size_t)(key0 >> 6) * 32768 + (h * 64) * 64; P.ldv = 64; P.vk32 = 0; P.nt = 16;
                    P.minit = -1e30f; P.linit = 0.f; P.rel_row0 = r0 - r + 7; P.tabh = h * 480 + (((r0 >> 1) & 3) << 12); P.dq0 = 0; P.jofs = 0; P.slope = 0.f;
                    att::attn_task<0>(P, tab, wl, lane);
                } else if (li < nA + nB) {
                    const int idx = xcd * nB + (li - nA), h = idx % 6, blk = idx / 6, tok0 = 64 * blk;
                    int tokbase, t0, T;
                    if (tok0 < NTOK_P) { tokbase = tok0 & ~4095; t0 = tok0 & 4095; T = 4096; } else { const int off = tok0 - NTOK_P; tokbase = NTOK_P + (off & ~2047); t0 = off & 2047; T = 2048; }
                    int jlo = 4 - (t0 >> 5); jlo = jlo < 0 ? 0 : jlo;
                    int jhi = ((T - t0) >> 5) + 3; jhi = jhi > 9 ? 9 : jhi;
                    const int sfirst = t0 - 128 + 32 * jlo, kvh = h / 3;
                    P.qrow_base = PROJ + ((size_t)(6 + h) * NTOK + tokbase + t0) * 64; P.grow_base = PROJ + ((size_t)(30 + h) * NTOK + tokbase + t0) * 64;
                    P.kbase = PROJ + ((size_t)(22 + kvh) * NTOK + tokbase + sfirst) * 64; P.ldk = 64;
                    P.vbase = VT + (384 + kvh * 64) * 64; P.ldv = 64; P.vk32 = (tokbase + sfirst) >> 5; P.nt = jhi - jlo + 1;
                    P.minit = a.sink[l * 6 + h] * LOG2E; P.linit = 1.f; P.rel_row0 = 0; P.tabh = 0;
                    P.dq0 = t0 - sfirst; P.jofs = jlo; P.slope = __builtin_amdgcn_exp2f(-8.0f * (float)(h + 1) / 6.0f) * LOG2E;
                    att::attn_task<1>(P, tab, wl, lane);
                } else {
                    const int idx = xcd * nC + (li - nA - nB), h = idx & 3, blk = idx >> 2, tok0 = 64 * blk;
                    const int bg = tok0 < NTOK_P ? (tok0 >> 12) : 4 + ((tok0 - NTOK_P) >> 11);
                    P.qrow_base = PROJ + ((size_t)(12 + h) * NTOK + tok0) * 64; P.grow_base = PROJ + ((size_t)(36 + h) * NTOK + tok0) * 64;
                    P.kbase = MEMK + (size_t)(bg * 256) * 1024 + l * 256 + h * 64; P.ldk = 1024;
                    P.vbase = MEMVT + (size_t)(l * 256 + h * 64) * LDMVT + bg * 256; P.ldv = LDMVT; P.vk32 = 0; P.nt = 8;
                    P.minit = -1e30f; P.linit = 0.f; P.rel_row0 = 0; P.tabh = 0; P.dq0 = 0; P.jofs = 0; P.slope = 0.f;
                    att::attn_task<2>(P, tab, wl, lane);
                }
                li = xcd_ok ? (int)(256u + (unsigned)__builtin_amdgcn_readfirstlane((int)nv)) : li + jstride;
            }
        }
        xcd_barrier(xbar, wave);
        STAMP(2);

        {
            pg8::Gemm g{PROJ, WOUT + (size_t)l * 1024 * 1024, NTOK, 1024, 1024, 64, 1024, PGRP * 2, 128}; pg8::StaticOrder S; S.init(NTOK, 1024, G, bx);
            pg8::EpiOut E{l == 0 ? a.x_prompt : a.out, l == 0 ? a.x_sample - (size_t)NTOK_P * DM : a.out, a.out, XB, ROWSS + (size_t)(l + 1 < DEPTH ? l + 1 : 0) * NTOK, l == DEPTH - 1 ? 1 : 0};
            pg8::gemm_phase<pg8::EpiOut, pg8::StaticOrder>(lds, g, S, E, wave);
        }
#ifdef PROBE_SEL
        grid.sync();
        STAMP(3);
#else
        if (l + 1 < DEPTH) xcd_barrier(xbar, wave);
#endif
    }
#ifdef PROBE_SEL
    if (bx == 0 && wave == 0 && lane_id() == 0) a.out[(size_t)NTOK_P * DM] += (float)tq[PROBE_SEL] * (0.01f / 50.0f);
#endif
}

extern "C" void kernel_launch(void* const* d_in, const int* in_sizes, int n_in, void* d_out, int out_size, void* d_ws, size_t ws_size, hipStream_t stream) {
    static int grid = 0;
    if (grid == 0) {
        if (n_in != 13 || ws_size < WS_END) { fprintf(stderr, "kernel_launch: unexpected n_in %d / ws %zu (need %zu)\n", n_in, ws_size, (size_t)WS_END); grid = -1; return; }
        int dev = 0, cus = 0, per_cu = 0;
        hipGetDevice(&dev);
        hipDeviceGetAttribute(&cus, hipDeviceAttributeMultiprocessorCount, dev);
        if (hipFuncSetAttribute((const void*)hymba_fwd, hipFuncAttributeMaxDynamicSharedMemorySize, LDS_BYTES) != hipSuccess) { fprintf(stderr, "kernel_launch: hipFuncSetAttribute failed\n"); grid = -1; return; }
        if (hipOccupancyMaxActiveBlocksPerMultiprocessor(&per_cu, (const void*)hymba_fwd, 512, LDS_BYTES) != hipSuccess || per_cu < 1) { fprintf(stderr, "kernel_launch: occupancy query failed (%d)\n", per_cu); (void)hipGetLastError(); per_cu = 1; }
        grid = cus * per_cu;
        fprintf(stderr, "kernel_launch: cus %d per_cu %d grid %d\n", cus, per_cu, grid);
    }
    if (grid < 0) return;
    Args a{};
    a.x_prompt = (const float*)d_in[0]; a.x_sample = (const float*)d_in[1]; a.mem_prompt = (const float*)d_in[2]; a.mem_sample = (const float*)d_in[3];
    a.norm_g = (const float*)d_in[4]; a.w_in = (const float*)d_in[5]; a.q_norm_g = (const float*)d_in[6]; a.k_norm_g = (const float*)d_in[7];
    a.rpb = (const float*)d_in[8]; a.sink = (const float*)d_in[9]; a.mem_norm_g = (const float*)d_in[10]; a.w_mem_kv = (const float*)d_in[11]; a.w_out = (const float*)d_in[12];
    a.out = (float*)d_out; a.ws = (unsigned char*)d_ws;
    if (hipMemsetAsync((char*)d_ws + WS_BAR, 0, XCD_BAR_WORDS * 4 + 32 * 256, stream) != hipSuccess) { fprintf(stderr, "kernel_launch: memset of the barrier words failed\n"); return; }
    void* args[] = {&a};
    hipError_t e = hipLaunchCooperativeKernel((const void*)hymba_fwd, dim3(grid), dim3(512), args, LDS_BYTES, stream);
    if (e != hipSuccess) fprintf(stderr, "kernel_launch: cooperative launch failed: %s (grid %d)\n", hipGetErrorString(e), grid);
}
```

```cpp
#include <hip/hip_runtime.h>
#include <hip/hip_cooperative_groups.h>
#include <cstdio>
#include <cstdint>
namespace cg = cooperative_groups;

#define LAS __attribute__((address_space(3)))
#define GAS __attribute__((address_space(1)))
#define DI __device__ __forceinline__
typedef unsigned short bf16_t;
typedef short bf16x8 __attribute__((ext_vector_type(8)));
typedef float f32x2 __attribute__((ext_vector_type(2)));
typedef float f32x4 __attribute__((ext_vector_type(4)));
typedef float f32x16 __attribute__((ext_vector_type(16)));
typedef unsigned u32x2 __attribute__((ext_vector_type(2)));
typedef unsigned u32x4 __attribute__((ext_vector_type(4)));
typedef __bf16 bf16x2_t __attribute__((ext_vector_type(2)));

DI int lane_id() { int x; asm volatile("v_mbcnt_lo_u32_b32 %0, -1, 0\n\tv_mbcnt_hi_u32_b32 %0, -1, %0" : "=&v"(x)); return x; }
DI unsigned pk2(float a, float b) { f32x2 v = {a, b}; bf16x2_t r = __builtin_convertvector(v, bf16x2_t); return __builtin_bit_cast(unsigned, r); }
DI void half_swap(float& a, float& b) { asm volatile("s_nop 1\n\tv_permlane32_swap_b32 %0, %1" : "+v"(a), "+v"(b)); }
DI float half_max(float x) { float a = x, b = x; half_swap(a, b); return fmaxf(a, b); }
DI float half_sum(float x) { float a = x, b = x; half_swap(a, b); return a + b; }
DI float bflo(unsigned u) { return __builtin_bit_cast(float, u << 16); }
DI float bfhi(unsigned u) { return __builtin_bit_cast(float, u & 0xffff0000u); }

constexpr int DM = 1024, NTOK_P = 16384, NTOK = 49152, DEPTH = 4, NMEMTOK = 5120;
constexpr int QLD = 64;
constexpr size_t PGRP = (size_t)NTOK * 64;
constexpr int LDP = 2560;
constexpr int LDVT = NTOK;
constexpr int LDMVT = NMEMTOK;
constexpr float LOG2E = 1.4426950408889634f;
constexpr float RMS_EPS = 1e-6f;
constexpr size_t MiB = 1u << 20;
constexpr size_t WS_ROWSS = 0, WS_MEMSS = 819200, WS_WIN = 1 * MiB, WS_WOUT = 25 * MiB, WS_WMK = 33 * MiB, WS_WMV = 35 * MiB, WS_MEMB = 37 * MiB,
                 WS_MEMK = 47 * MiB, WS_MEMVT = 57 * MiB, WS_XB = 68 * MiB, WS_PROJ = 164 * MiB, WS_VT = 404 * MiB, WS_END = 452 * MiB;
constexpr int LDS_BYTES = 147456;

namespace pg8 {
constexpr int BM = 256, BK = 64, HALF = 128, HTB = HALF * BK * 2, STAGE_BYTES = 8 * HTB, NXCD = 8, WGM = 8;
__host__ __device__ __forceinline__ int lds_byte(int r, int c) { const int st = (r >> 4) * 2 + (c >> 5), rr = r & 15, cc = c & 31, ob = rr * 64 + cc * 2; return st * 1024 + (ob ^ (((ob >> 9) & 1) << 5)); }
__host__ __device__ __forceinline__ void stage_rc(int b, int& R, int& C) { const int st = b / 1024, sb = b % 1024, swz = sb ^ (((sb >> 9) & 1) << 5); R = (st >> 1) * 16 + swz / 64; C = (st & 1) * 32 + (swz % 64) / 2; }
__host__ __device__ __forceinline__ int perm32(int rho) { const int n = rho >> 4, i = rho & 15; return 8 * (i >> 2) + 4 * n + (i & 3); }

struct Unit { int pm, pn; };
struct Gemm { const bf16_t* A; const bf16_t* Bt; int M, N, K, lda, ldb; size_t ksA, ksB; };

struct StaticOrder {
    int nM, nN, nwg, G, c;
    __device__ void init(int M, int N, int G_, int c_) { nM = M / BM; nN = N / BM; nwg = nM * nN; G = G_; c = c_; }
    __device__ bool next(int i, Unit& u) const {
        const long L = (long)i * G + c; if (L >= nwg) return false;
        int wgid = (int)L; { const int q = nwg / NXCD, r = nwg % NXCD, xcd = wgid % NXCD, off = wgid / NXCD; wgid = (xcd < r ? xcd * (q + 1) : r * (q + 1) + (xcd - r) * q) + off; }
        const int nig = WGM * nN, gid = wgid / nig, fm = gid * WGM, gsz = (nM - fm) < WGM ? (nM - fm) : WGM;
        u.pm = fm + ((wgid % nig) % gsz); u.pn = (wgid % nig) / gsz; return true;
    }
};

template <class Epi, class Sched>
DI void gemm_phase(LAS unsigned char* lds, const Gemm g, const Sched& S, const Epi& E, int wave_) {
    int tid_ = wave_ * 64 + lane_id(); asm volatile("" : "+v"(tid_));
    const int tid = tid_, wid = __builtin_amdgcn_readfirstlane(tid >> 6), lane = tid & 63, wr = wid >> 2, wc = wid & 3, fr = lane & 15, fq = lane >> 4;
    const int K = g.K, nt = K / BK;
    unsigned voffA[2], voffB[2];
#pragma unroll
    for (int i = 0; i < 2; ++i) { int R, C; stage_rc(tid * 16 + i * 8192, R, C); const int Rb = (R & ~31) + perm32(R & 31);
        voffA[i] = (unsigned)(R * g.lda + C) * 2u; voffB[i] = (unsigned)(Rb * g.ldb + C) * 2u; }
    const size_t kstepA = g.ksA, kstepB = g.ksB;
    const size_t hstepA = (size_t)HALF * g.lda * 2, tstepA = 2 * hstepA, hstepB = (size_t)HALF * g.ldb * 2, tstepB = 2 * hstepB;
    const unsigned ldsw = (unsigned)wid * 1024u;
    const int aoff = lds_byte(wr * 64 + fr, fq * 8), boff = lds_byte(wc * 32 + fr, fq * 8);
#define PG8_SA(b, h) (((b) * 2 + (h)) * HTB)
#define PG8_SB(b, h) ((4 + (b) * 2 + (h)) * HTB)
#define PG8_STAGE(bufoff, gbase, voff) do { _Pragma("unroll") for (int _i = 0; _i < 2; ++_i) \
        __builtin_amdgcn_global_load_lds((const unsigned*)((const char*)(gbase) + (voff)[_i]), (LAS unsigned*)(lds + (bufoff) + ldsw + _i * 8192), 16, 0, 0); } while (0)
#define PG8_LDA(dst, b, h) do { _Pragma("unroll") for (int m = 0; m < 4; ++m) _Pragma("unroll") for (int k = 0; k < 2; ++k) dst[m][k] = *(const LAS bf16x8*)(lds + PG8_SA(b, h) + aoff + m * 2048 + k * 1024); } while (0)
#define PG8_LDB(dst, b, h) do { _Pragma("unroll") for (int n = 0; n < 2; ++n) _Pragma("unroll") for (int k = 0; k < 2; ++k) dst[n][k] = *(const LAS bf16x8*)(lds + PG8_SB(b, h) + boff + n * 2048 + k * 1024); } while (0)
#define PG8_MMA(ai, bj, At, Bt) do { __builtin_amdgcn_s_setprio(1); _Pragma("unroll") for (int m = 0; m < 4; ++m) _Pragma("unroll") for (int n = 0; n < 2; ++n) _Pragma("unroll") for (int k = 0; k < 2; ++k) \
        acc[ai][bj][m][n] = __builtin_amdgcn_mfma_f32_16x16x32_bf16(Bt[n][k], At[m][k], acc[ai][bj][m][n], 0, 0, 0); __builtin_amdgcn_s_setprio(0); } while (0)
#define PG8_WAIT_V(n) asm volatile("s_waitcnt vmcnt(" #n ")" ::: "memory")
#define PG8_WAIT_L(n) asm volatile("s_waitcnt lgkmcnt(" #n ")" ::: "memory")
#define PG8_BAR __builtin_amdgcn_s_barrier()
#define PG8_SCHED __builtin_amdgcn_sched_barrier(0)
    Unit cur, nxt; int ui = 0;
    if (!S.next(0, cur)) return;
    f32x4 acc[2][2][4][2];
#pragma unroll
    for (int a = 0; a < 2; ++a)
#pragma unroll
        for (int b = 0; b < 2; ++b)
#pragma unroll
            for (int m = 0; m < 4; ++m)
#pragma unroll
                for (int n = 0; n < 2; ++n) acc[a][b][m][n] = (f32x4){0.f, 0.f, 0.f, 0.f};
    bf16x8 At[4][2], B0[2][2], B1[2][2];
    const char* cA = (const char*)g.A + (size_t)cur.pm * tstepA; const char* cB = (const char*)g.Bt + (size_t)cur.pn * tstepB;
    PG8_STAGE(PG8_SB(0, 0), cB, voffB); PG8_STAGE(PG8_SB(0, 1), cB + hstepB, voffB); PG8_STAGE(PG8_SA(0, 0), cA, voffA); PG8_STAGE(PG8_SA(0, 1), cA + hstepA, voffA);
    if (wr == 1) PG8_BAR;
    PG8_WAIT_V(2); PG8_BAR;
    PG8_STAGE(PG8_SB(1, 0), cB + kstepB, voffB); PG8_STAGE(PG8_SA(1, 0), cA + kstepA, voffA); PG8_STAGE(PG8_SB(1, 1), cB + hstepB + kstepB, voffB);
    PG8_WAIT_V(6); PG8_BAR;
    for (;;) {
        const bool has_next = S.next(ui + 1, nxt);
        const char* nA = has_next ? (const char*)g.A + (size_t)nxt.pm * tstepA : cA; const char* nB = has_next ? (const char*)g.Bt + (size_t)nxt.pn * tstepB : cB;
        for (int t = 0; t < nt; t += 2) {
            const bool last = (t == nt - 2);
            const char* a1 = cA + (size_t)(t + 1) * kstepA;
            const char* a2 = last ? nA : cA + (size_t)(t + 2) * kstepA; const char* b2 = last ? nB : cB + (size_t)(t + 2) * kstepB;
            const char* a3 = a2 + kstepA; const char* b3 = b2 + kstepB;
            PG8_LDB(B0, 0, 0); PG8_LDB(B1, 0, 1); PG8_SCHED; PG8_LDA(At, 0, 0); PG8_STAGE(PG8_SA(1, 1), a1 + hstepA, voffA);
            PG8_WAIT_V(8); PG8_WAIT_L(0); PG8_BAR; PG8_MMA(0, 0, At, B0); PG8_MMA(0, 1, At, B1); PG8_BAR; PG8_SCHED;
            PG8_LDA(At, 0, 1); PG8_STAGE(PG8_SB(0, 0), b2, voffB); PG8_STAGE(PG8_SB(0, 1), b2 + hstepB, voffB); PG8_STAGE(PG8_SA(0, 0), a2, voffA);
            PG8_WAIT_V(8); PG8_WAIT_L(0); PG8_BAR; PG8_MMA(1, 0, At, B0); PG8_MMA(1, 1, At, B1); PG8_BAR; PG8_SCHED;
            PG8_LDB(B0, 1, 0); PG8_LDB(B1, 1, 1); PG8_SCHED; PG8_LDA(At, 1, 0); PG8_STAGE(PG8_SA(0, 1), a2 + hstepA, voffA);
            PG8_WAIT_V(8); PG8_WAIT_L(0); PG8_BAR; PG8_MMA(0, 0, At, B0); PG8_MMA(0, 1, At, B1); PG8_BAR; PG8_SCHED;
            PG8_LDA(At, 1, 1); PG8_STAGE(PG8_SB(1, 0), b3, voffB); PG8_STAGE(PG8_SB(1, 1), b3 + hstepB, voffB); PG8_STAGE(PG8_SA(1, 0), a3, voffA);
            PG8_WAIT_V(8); PG8_WAIT_L(0); PG8_BAR; PG8_MMA(1, 0, At, B0); PG8_MMA(1, 1, At, B1); PG8_BAR; PG8_SCHED;
        }
        if (wr == 0) PG8_BAR;
        E(acc, cur, wr, wc, fr, fq);
        if (!has_next) break;
#pragma unroll
        for (int a = 0; a < 2; ++a)
#pragma unroll
            for (int b = 0; b < 2; ++b)
#pragma unroll
                for (int m = 0; m < 4; ++m)
#pragma unroll
                    for (int n = 0; n < 2; ++n) acc[a][b][m][n] = (f32x4){0.f, 0.f, 0.f, 0.f};
        cur = nxt; cA = nA; cB = nB; ++ui;
        if (wr == 1) PG8_BAR;
    }
    PG8_WAIT_V(0);
    PG8_BAR;
#undef PG8_SA
#undef PG8_SB
#undef PG8_STAGE
#undef PG8_LDA
#undef PG8_LDB
#undef PG8_MMA
#undef PG8_WAIT_V
#undef PG8_WAIT_L
#undef PG8_BAR
#undef PG8_SCHED
}

struct EpiRow {
    bf16_t* O; int ldc; const float* rowss; const float* qg; const float* kg; int mode; int blocked;
    DI void operator()(const f32x4 (&acc)[2][2][4][2], const Unit& u, int wr, int wc, int fr, int fq) const {
        const int row0 = u.pm * BM + wr * 64 + fr, col0 = u.pn * BM + 64 * wc + 8 * fq;
        int type; const float* gam = kg; float gsc = 1.f;
        if (mode == 1) { type = 1; gam = kg + u.pn * 192 + 128; }
        else if (u.pn < 4) { type = 0; const int hd = 4 * u.pn + wc; gam = qg + (hd < 6 ? 0 : (hd < 12 ? 64 : 128)); gsc = 0.125f * LOG2E; }
        else if (u.pn < 6) { type = 1; const int hd = 4 * (u.pn - 4) + wc; gam = kg + (hd < 6 ? 0 : 64); }
        else type = 2;
        f32x4 gv[2][2];
#pragma unroll
        for (int bj = 0; bj < 2; ++bj)
#pragma unroll
            for (int n = 0; n < 2; ++n) gv[bj][n] = (type < 2) ? *(const f32x4*)(gam + 32 * bj + 8 * fq + 4 * n) * gsc : (f32x4){1.f, 1.f, 1.f, 1.f};
        float rsv[2][4];
#pragma unroll
        for (int ai = 0; ai < 2; ++ai)
#pragma unroll
            for (int m = 0; m < 4; ++m) rsv[ai][m] = ((const GAS float*)rowss)[row0 + ai * HALF + m * 16];
#pragma unroll
        for (int ai = 0; ai < 2; ++ai)
#pragma unroll
            for (int m = 0; m < 4; ++m) {
                const int row = row0 + ai * HALF + m * 16;
                const float rs = __builtin_amdgcn_rsqf(rsv[ai][m] * (1.0f / 1024.0f) + RMS_EPS);
                f32x4 v[2][2]; float ss = 0.f;
#pragma unroll
                for (int bj = 0; bj < 2; ++bj)
#pragma unroll
                    for (int n = 0; n < 2; ++n) { v[bj][n] = acc[ai][bj][m][n] * rs; const f32x4 x = v[bj][n]; ss += (x[0] * x[0] + x[1] * x[1]) + (x[2] * x[2] + x[3] * x[3]); }
                if (type < 2) {
                    ss += __shfl_xor(ss, 16); ss = half_sum(ss);
                    const float rn = __builtin_amdgcn_rsqf(ss * (1.0f / 64.0f) + RMS_EPS);
#pragma unroll
                    for (int bj = 0; bj < 2; ++bj)
#pragma unroll
                        for (int n = 0; n < 2; ++n) v[bj][n] = v[bj][n] * rn * gv[bj][n];
                } else {
#pragma unroll
                    for (int bj = 0; bj < 2; ++bj)
#pragma unroll
                        for (int n = 0; n < 2; ++n)
#pragma unroll
                            for (int j = 0; j < 4; ++j) { const float x = v[bj][n][j]; v[bj][n][j] = x * __builtin_amdgcn_rcpf(1.0f + __builtin_amdgcn_exp2f(-x * LOG2E)); }
                }
                GAS bf16_t* rowp = blocked ? (GAS bf16_t*)O + ((size_t)(4 * u.pn + wc) * NTOK + row) * 64 + 8 * fq : (GAS bf16_t*)O + (size_t)row * ldc + col0;
#pragma unroll
                for (int bj = 0; bj < 2; ++bj) { u32x4 w; w.x = pk2(v[bj][0][0], v[bj][0][1]); w.y = pk2(v[bj][0][2], v[bj][0][3]); w.z = pk2(v[bj][1][0], v[bj][1][1]); w.w = pk2(v[bj][1][2], v[bj][1][3]);
                    *(GAS u32x4*)(rowp + 32 * bj) = w; }
            }
    }
};
struct EpiCol {
    bf16_t* O; int ldc; const float* colss; int blocked;
    DI void operator()(const f32x4 (&acc)[2][2][4][2], const Unit& u, int wr, int wc, int fr, int fq) const {
        const int row0 = u.pm * BM + wr * 64 + fr, col0 = u.pn * BM + 32 * wc + 8 * fq;
        f32x4 rs[2][2];
#pragma unroll
        for (int bj = 0; bj < 2; ++bj)
#pragma unroll
            for (int n = 0; n < 2; ++n) { const f32x4 s = *(const GAS f32x4*)((const GAS float*)colss + col0 + HALF * bj + 4 * n);
#pragma unroll
                for (int j = 0; j < 4; ++j) rs[bj][n][j] = __builtin_amdgcn_rsqf(s[j] * (1.0f / 1024.0f) + RMS_EPS); }
#pragma unroll
        for (int ai = 0; ai < 2; ++ai)
#pragma unroll
            for (int m = 0; m < 4; ++m) { const int row = row0 + ai * HALF + m * 16;
                GAS bf16_t* rowp = blocked ? (GAS bf16_t*)O + ((size_t)(col0 >> 6) * 512 + row) * 64 + (col0 & 63) : (GAS bf16_t*)O + (size_t)row * ldc + col0;
                const size_t bjstep = blocked ? (size_t)2 * 32768 : (size_t)HALF;
#pragma unroll
                for (int bj = 0; bj < 2; ++bj) { const f32x4 v0 = acc[ai][bj][m][0] * rs[bj][0], v1 = acc[ai][bj][m][1] * rs[bj][1];
                    u32x4 w; w.x = pk2(v0[0], v0[1]); w.y = pk2(v0[2], v0[3]); w.z = pk2(v1[0], v1[1]); w.w = pk2(v1[2], v1[3]);
                    *(GAS u32x4*)(rowp + bjstep * bj) = w; } }
    }
};
struct EpiOut {
    const float* xin_p; const float* xin_s; float* out; bf16_t* xb; float* ss_next; int last;
    DI void operator()(const f32x4 (&acc)[2][2][4][2], const Unit& u, int wr, int wc, int fr, int fq) const {
        const int row0 = u.pm * BM + wr * 64 + fr, col0 = u.pn * BM + 32 * wc + 8 * fq;
        const GAS float* xin = (const GAS float*)((u.pm < NTOK_P / BM) ? xin_p : xin_s);
        GAS float* outg = (GAS float*)out; GAS bf16_t* xbg = (GAS bf16_t*)xb;
#pragma unroll
        for (int ai = 0; ai < 2; ++ai) {
            f32x4 xv[4][2][2];
#pragma unroll
            for (int m = 0; m < 4; ++m) { const size_t off = (size_t)(row0 + ai * HALF + m * 16) * DM + col0;
#pragma unroll
                for (int bj = 0; bj < 2; ++bj)
#pragma unroll
                    for (int n = 0; n < 2; ++n) xv[m][bj][n] = *(const GAS f32x4*)(xin + off + HALF * bj + 4 * n); }
#pragma unroll
            for (int m = 0; m < 4; ++m) { const int row = row0 + ai * HALF + m * 16; const size_t off = (size_t)row * DM + col0; float ss = 0.f;
#pragma unroll
                for (int bj = 0; bj < 2; ++bj) { f32x4 v[2];
#pragma unroll
                    for (int n = 0; n < 2; ++n) { v[n] = xv[m][bj][n] + acc[ai][bj][m][n]; __builtin_nontemporal_store(v[n], (GAS f32x4*)(outg + off + HALF * bj + 4 * n));
                        ss += (v[n][0] * v[n][0] + v[n][1] * v[n][1]) + (v[n][2] * v[n][2] + v[n][3] * v[n][3]); }
                    if (!last) { u32x4 w; w.x = pk2(v[0][0], v[0][1]); w.y = pk2(v[0][2], v[0][3]); w.z = pk2(v[1][0], v[1][1]); w.w = pk2(v[1][2], v[1][3]); *(GAS u32x4*)(xbg + off + HALF * bj) = w; } }
                if (!last) { ss += __shfl_xor(ss, 16); ss = half_sum(ss); if (fq == 0) atomicAdd(ss_next + row, ss); } }
        }
    }
};
}

namespace att {
#define MFMA32(a, b, c) __builtin_amdgcn_mfma_f32_32x32x16_bf16((a), (b), (c), 0, 0, 0)
constexpr int TAB_OFF = 131072;
struct TaskP {
    bf16_t* qrow_base;
    const bf16_t* grow_base;
    const bf16_t* kbase;
    const bf16_t* vbase;
    int ldk, ldv, nt;
    float minit, linit;
    int rel_row0, tabh;
    int vk32;
    int dq0, jofs; float slope;
};
template <int KIND>
DI void attn_task(const TaskP& P, const LAS float* tab, LAS unsigned char* wl, int lane) {
    const int q = lane & 31, hh = lane >> 5;
    const int pil = (q & 0x13) | ((q & 4) << 1) | ((q & 8) >> 1);
    GAS bf16_t* qrow = (GAS bf16_t*)P.qrow_base + q * QLD;
    bf16x8 qf[2][4];
#pragma unroll
    for (int u = 0; u < 2; ++u)
#pragma unroll
        for (int ks = 0; ks < 4; ++ks) qf[u][ks] = *(const GAS bf16x8*)(qrow + (32 * u) * QLD + 32 * hh + 8 * ks);
    f32x16 oa[2], ob[2];
#pragma unroll
    for (int u = 0; u < 2; ++u)
#pragma unroll
        for (int i = 0; i < 16; ++i) { oa[u][i] = 0.f; ob[u][i] = 0.f; }
    float mrun[2], lrun[2];
    mrun[0] = mrun[1] = P.minit; lrun[0] = lrun[1] = (hh == 0) ? P.linit : 0.f;
    const int l3 = lane >> 3, l4 = lane >> 4;
    const int vc = (lane & 3) ^ (l4 & 3);
    const GAS bf16_t* kg = (const GAS bf16_t*)P.kbase;
    const GAS bf16_t* vg0 = (const GAS bf16_t*)P.vbase;
    const unsigned kro0 = (unsigned)(pil * 128 + (((4 * hh) ^ ((pil >> 1) & 7)) * 16));
    const unsigned vro0 = (unsigned)(4096 + pil * 64 + ((hh ^ ((pil >> 2) & 3)) * 16));
    const int kca = (lane & 7) ^ (l4 & 7);
    const unsigned kof0 = (unsigned)(l3 * P.ldk + 8 * kca) * 2u;
    const unsigned vof0 = (unsigned)((lane >> 2) * P.ldv + ((KIND == 0) ? ((vc >> 1) * 32768 + 8 * (vc & 1)) : (8 * vc))) * 2u;
#define ATT_RP(t_) ((((t_) >> 2) - (P.tabh >> 12)) & 3)
#define ATT_TILEKEY(t_) ((KIND == 0) ? (128 * ATT_RP(t_) + 16 * ((t_) & 3)) : (32 * (t_)))
#define ATT_KROW(i_) ((KIND == 0) ? (((i_) >> 1) * 64 + 8 * ((i_) & 1)) : (8 * (i_)))
#define ATT_PIECE_K(t_, buf_, i_) do { const GAS char* kt_ = (const GAS char*)(kg + (size_t)(ATT_TILEKEY(t_) + ATT_KROW(i_)) * P.ldk); \
        __builtin_amdgcn_global_load_lds((const GAS unsigned*)(kt_ + (((i_) & 1) ? (kof0 ^ 64u) : kof0)), (LAS unsigned*)(wl + (buf_) * 8192 + (i_) * 1024), 16, 0, 0); } while (0)
#define ATT_TILEKEY_V(t_) ((KIND == 0) ? (65536 * ATT_RP(t_) + 16 * ((t_) & 3)) : (KIND == 1) ? ((((P.vk32 + (t_)) >> 1) * 32768) + ((P.vk32 + (t_)) & 1) * 32) : (32 * (t_)))
#define ATT_PIECE_V(t_, buf_, i_) do { const GAS char* vt_ = (const GAS char*)(vg0 + (size_t)(16 * (i_)) * P.ldv + ATT_TILEKEY_V(t_)); \
        __builtin_amdgcn_global_load_lds((const GAS unsigned*)(vt_ + vof0), (LAS unsigned*)(wl + (buf_) * 8192 + 4096 + (i_) * 1024), 16, 0, 0); } while (0)
#pragma unroll
    for (int i = 0; i < 4; ++i) ATT_PIECE_K(0, 0, i);
#pragma unroll
    for (int i = 0; i < 4; ++i) ATT_PIECE_V(0, 0, i);
    if (P.nt > 1) {
#pragma unroll
        for (int i = 0; i < 4; ++i) ATT_PIECE_K(1, 1, i);
    }
    for (int t = 0; t < P.nt; ++t) {
        asm volatile("" ::: "memory");
        if (t + 1 < P.nt) asm volatile("s_waitcnt vmcnt(8)" ::: "memory"); else asm volatile("s_waitcnt vmcnt(4)" ::: "memory");
        const LAS unsigned char* bb = wl + (t & 1) * 8192;
        const bool moreK = (t + 2 < P.nt), moreV = (t + 1 < P.nt);
        bool act[2];
#pragma unroll
        for (int u = 0; u < 2; ++u) { act[u] = true;
            if (KIND == 0) { const int cb = t & 3; act[u] = !(cb < u || cb > u + 2); }
            if (KIND == 1) { const int j = P.jofs + t; act[u] = !(j < u || j > u + 8); } }
        f32x16 sv[2];
        {
            bf16x8 kf[4];
#pragma unroll
            for (int ks = 0; ks < 4; ++ks) kf[ks] = *(const LAS bf16x8*)(bb + (kro0 ^ (16u * ks)));
#pragma unroll
            for (int u = 0; u < 2; ++u) {
#pragma unroll
                for (int i = 0; i < 16; ++i) sv[u][i] = 0.f;
                if (act[u]) {
                    __builtin_amdgcn_s_setprio(1);
#pragma unroll
                    for (int ks = 0; ks < 4; ++ks) sv[u] = MFMA32(kf[ks], qf[u][ks], sv[u]);
                    __builtin_amdgcn_s_setprio(0);
                }
            }
        }
        asm volatile("s_waitcnt lgkmcnt(0)" ::: "memory");
        bf16x8 pb[2][2];
#pragma unroll
        for (int u = 0; u < 2; ++u) {
            f32x16 s = sv[u];
            float mn = 0.f;
            if (act[u]) {
                if (KIND == 0) {
                    const int rp = ATT_RP(t), cb = t & 3;
                    const int qc = 32 * u + q;
                    const int cs = qc - 8 < 0 ? 0 : (qc - 8 > 48 ? 48 : qc - 8);
                    const int kcb = 16 * cb + 8 * hh;
                    const int db = kcb - qc + 15, mb = kcb - cs;
                    const LAS float* tr0 = tab + ((P.tabh & 4095) + (P.rel_row0 + 2 * rp) * 32 + db);
                    const unsigned taddr = (unsigned)(size_t)tr0;
#pragma unroll
                    for (int hb = 0; hb < 2; ++hb) {
                        float bz[8]; const unsigned ta2 = taddr + 128u * hb;
                        asm volatile("ds_read_b32 %0, %8\n\tds_read_b32 %1, %8 offset:4\n\tds_read_b32 %2, %8 offset:8\n\tds_read_b32 %3, %8 offset:12\n\t"
                                     "ds_read_b32 %4, %8 offset:16\n\tds_read_b32 %5, %8 offset:20\n\tds_read_b32 %6, %8 offset:24\n\tds_read_b32 %7, %8 offset:28\n\t"
                                     "s_waitcnt lgkmcnt(0)"
                                     : "=&v"(bz[0]), "=&v"(bz[1]), "=&v"(bz[2]), "=&v"(bz[3]), "=&v"(bz[4]), "=&v"(bz[5]), "=&v"(bz[6]), "=&v"(bz[7])
                                     : "v"(ta2) : "memory");
#pragma unroll
                        for (int ci = 0; ci < 8; ++ci) { const bool valid = (unsigned)(mb + ci) < 16u;
                            s[8 * hb + ci] = valid ? s[8 * hb + ci] + bz[ci] : -INFINITY; }
                    }
                } else if (KIND == 1) {
                    const float fdq = (float)(P.dq0 + 32 * u + q - 8 * hh - 32 * t);
                    const int jrel = P.jofs + t - u;
                    if (jrel >= 1 && jrel <= 7) {
#pragma unroll
                        for (int i = 0; i < 16; ++i) { const float ci = (float)((i & 7) + 16 * (i >> 3)); s[i] = s[i] - P.slope * fabsf(fdq - ci); }
                    } else {
#pragma unroll
                        for (int i = 0; i < 16; ++i) { const float ci = (float)((i & 7) + 16 * (i >> 3));
                            const float ad = fabsf(fdq - ci);
                            s[i] = ad <= 128.f ? s[i] - P.slope * ad : -INFINITY; }
                    }
                }
                float mx = fmaxf(s[0], s[1]);
#pragma unroll
                for (int i = 2; i < 16; ++i) mx = fmaxf(mx, s[i]);
                mx = half_max(mx);
                const float mold = mrun[u];
                mn = (mx > mold + 8.f) ? mx : mold;
                if (__builtin_amdgcn_ballot_w64(mn != mold)) {
                    const float alpha = __builtin_amdgcn_exp2f(mold - mn);
                    lrun[u] *= alpha;
#pragma unroll
                    for (int i = 0; i < 16; ++i) { oa[u][i] *= alpha; ob[u][i] *= alpha; }
                    mrun[u] = mn;
                }
            }
            __builtin_amdgcn_sched_barrier(0);
            if (moreK) { ATT_PIECE_K(t + 2, t & 1, 2 * u); ATT_PIECE_K(t + 2, t & 1, 2 * u + 1); }
            __builtin_amdgcn_sched_barrier(0);
            if (act[u]) {
                float ps0 = 0.f, ps1 = 0.f;
#pragma unroll
                for (int i = 0; i < 16; i += 2) { s[i] = __builtin_amdgcn_exp2f(s[i] - mn); s[i + 1] = __builtin_amdgcn_exp2f(s[i + 1] - mn); ps0 += s[i]; ps1 += s[i + 1]; }
                lrun[u] += ps0 + ps1;
#pragma unroll
                for (int sx = 0; sx < 2; ++sx) { u32x4 w; w.x = pk2(s[8 * sx], s[8 * sx + 1]); w.y = pk2(s[8 * sx + 2], s[8 * sx + 3]); w.z = pk2(s[8 * sx + 4], s[8 * sx + 5]); w.w = pk2(s[8 * sx + 6], s[8 * sx + 7]);
                    pb[u][sx] = __builtin_bit_cast(bf16x8, w); }
            }
            __builtin_amdgcn_sched_barrier(0);
            if (moreV) { ATT_PIECE_V(t + 1, (t + 1) & 1, 2 * u); ATT_PIECE_V(t + 1, (t + 1) & 1, 2 * u + 1); }
            __builtin_amdgcn_sched_barrier(0);
        }
        if (moreK) asm volatile("s_waitcnt vmcnt(8)" ::: "memory");
        else if (moreV) asm volatile("s_waitcnt vmcnt(4)" ::: "memory");
        else asm volatile("s_waitcnt vmcnt(0)" ::: "memory");
        {
            bf16x8 vf[4];
            vf[0] = *(const LAS bf16x8*)(bb + vro0); vf[1] = *(const LAS bf16x8*)(bb + (vro0 ^ 32u));
            vf[2] = *(const LAS bf16x8*)(bb + vro0 + 2048); vf[3] = *(const LAS bf16x8*)(bb + (vro0 ^ 32u) + 2048);
#pragma unroll
            for (int u = 0; u < 2; ++u) {
                if (!act[u]) continue;
                __builtin_amdgcn_s_setprio(1);
                oa[u] = MFMA32(vf[0], pb[u][0], oa[u]); oa[u] = MFMA32(vf[1], pb[u][1], oa[u]);
                ob[u] = MFMA32(vf[2], pb[u][0], ob[u]); ob[u] = MFMA32(vf[3], pb[u][1], ob[u]);
                __builtin_amdgcn_s_setprio(0);
            }
        }
        asm volatile("s_waitcnt lgkmcnt(0)" ::: "memory");
    }
#undef ATT_PIECE_K
#undef ATT_TILEKEY
#undef ATT_RP
#undef ATT_TILEKEY_V
#undef ATT_KROW
#undef ATT_PIECE_V
    u32x4 gtv[2][4];
#pragma unroll
    for (int u = 0; u < 2; ++u) { const GAS bf16_t* grow = (const GAS bf16_t*)P.grow_base + (32 * u + q) * QLD + 8 * hh;
#pragma unroll
        for (int c = 0; c < 4; ++c) gtv[u][c] = *(const GAS u32x4*)(grow + 16 * c); }
#pragma unroll
    for (int u = 0; u < 2; ++u) {
        const float lt = half_sum(lrun[u]);
        const float inv = __builtin_amdgcn_rcpf(lt);
        GAS bf16_t* orow = qrow + (32 * u) * QLD;
#pragma unroll
        for (int db = 0; db < 2; ++db)
#pragma unroll
            for (int g = 0; g < 2; ++g) { const int d0 = 32 * db + 16 * g + 8 * hh;
                const u32x4 gt = gtv[u][2 * db + g];
                float ov[8];
#pragma unroll
                for (int j = 0; j < 8; ++j) ov[j] = (db == 0 ? oa[u][8 * g + j] : ob[u][8 * g + j]) * inv;
                u32x4 w; w.x = pk2(ov[0] * bflo(gt.x), ov[1] * bfhi(gt.x)); w.y = pk2(ov[2] * bflo(gt.y), ov[3] * bfhi(gt.y));
                w.z = pk2(ov[4] * bflo(gt.z), ov[5] * bfhi(gt.z)); w.w = pk2(ov[6] * bflo(gt.w), ov[7] * bfhi(gt.w));
                *(GAS u32x4*)(orow + d0) = w; }
    }
}
}


#define XB_TMO      128
#define XB_XCNT(j)  (256  + 64 * (j))
#define XB_XSUB(j)  (1280 + 64 * (j))
#define XB_XGEN(j)  (2304 + 64 * (j))
#define XB_TOP      3328
#define XB_TOPGEN   3392
#define XCD_BAR_WORDS 3456
#define XB_SPIN_CAP (1u << 22)
DI unsigned xb_ld(unsigned* p)              { return __hip_atomic_load(p, __ATOMIC_RELAXED, __HIP_MEMORY_SCOPE_AGENT); }
DI unsigned xb_add(unsigned* p, unsigned v) { return __hip_atomic_fetch_add(p, v, __ATOMIC_RELAXED, __HIP_MEMORY_SCOPE_AGENT); }
DI unsigned xb_xcc_id() { return (unsigned)__builtin_amdgcn_s_getreg((3 << 11) | 20) & 0xFu; }
#define XB_SPIN(cond, bar) do { unsigned _sp = 0; while (cond) { __builtin_amdgcn_s_sleep(1); \
    if ((++_sp & 255u) == 0u) { if (xb_ld(&(bar)[XB_TMO])) break; if (_sp > XB_SPIN_CAP) { atomicAdd(&(bar)[XB_TMO], 1u); break; } } } } while (0)
struct XcdBarrier { unsigned* bar; unsigned x; volatile LAS unsigned* st; };
DI XcdBarrier xcd_barrier_post(unsigned* bar, volatile LAS unsigned* st, bool t0) {
    XcdBarrier b; b.bar = bar; b.x = xb_xcc_id(); b.st = st;
    if (t0) (void)xb_add(&bar[XB_XCNT(b.x)], 1u);
    return b;
}
DI void xcd_barrier_complete(unsigned* bar, unsigned x, unsigned& nloc, unsigned& nx) {
    const unsigned G = gridDim.x * gridDim.y * gridDim.z;
    unsigned sum, cnt, mine, sp = 0u;
    for (;;) {
        sum = 0u; cnt = 0u; mine = 0u;
#pragma unroll
        for (unsigned j = 0; j < 16; ++j) { const unsigned c = xb_ld(&bar[XB_XCNT(j)]); sum += c; cnt += (c > 0u) ? 1u : 0u; mine = (j == x) ? c : mine; }
        if (sum == G) break;
        __builtin_amdgcn_s_sleep(1);
        if ((++sp & 255u) == 0u) { if (xb_ld(&bar[XB_TMO])) break; if (sp > XB_SPIN_CAP) { atomicAdd(&bar[XB_TMO], 1u); break; } }
    }
    nloc = mine > 0u ? mine : 1u; nx = cnt > 0u ? cnt : 1u;
}
DI void xcd_barrier(const XcdBarrier& b, int wave_) {
    const bool t0 = (wave_ == 0) && (lane_id() == 0);
    asm volatile("s_waitcnt vmcnt(0)" ::: "memory");
    __syncthreads();
    if (t0) {
        unsigned* bar = b.bar;
        __builtin_amdgcn_s_waitcnt(0);
        unsigned nloc = b.st[0], nx = b.st[1];
        if (nloc == 0u) { xcd_barrier_complete(bar, b.x, nloc, nx); b.st[0] = nloc; b.st[1] = nx; }
        const unsigned old = xb_add(&bar[XB_XSUB(b.x)], 1u);
        const unsigned gen = old / nloc;
        if (old + 1u == (gen + 1u) * nloc) {
            __builtin_amdgcn_fence(__ATOMIC_RELEASE, "agent");
            asm volatile("s_waitcnt vmcnt(0)" ::: "memory");
            const unsigned og = xb_add(&bar[XB_TOP], 1u);
            const unsigned tg = og / nx;
            if (og + 1u == (tg + 1u) * nx) xb_add(&bar[XB_TOPGEN], 1u);
            else XB_SPIN(xb_ld(&bar[XB_TOPGEN]) == tg, bar);
            __builtin_amdgcn_fence(__ATOMIC_ACQUIRE, "agent");
            xb_add(&bar[XB_XGEN(b.x)], 1u);
            asm volatile("s_waitcnt vmcnt(0)" ::: "memory");
        } else {
            XB_SPIN(xb_ld(&bar[XB_XGEN(b.x)]) == gen, bar);
            __builtin_amdgcn_fence(__ATOMIC_ACQUIRE, "agent");
            asm volatile("s_waitcnt vmcnt(0)" ::: "memory");
        }
    }
    __syncthreads();
}
constexpr size_t WS_BAR = 901120;
constexpr size_t WS_TAB = 950272;
constexpr size_t WS_CTR = WS_BAR + 13824;
constexpr int LDS_BARST = 143360;

struct Args {
    const float *x_prompt, *x_sample, *mem_prompt, *mem_sample, *norm_g, *w_in, *q_norm_g, *k_norm_g, *rpb, *sink, *mem_norm_g, *w_mem_kv, *w_out;
    float* out; unsigned char* ws;
};
#define LDS_WAIT() asm volatile("s_waitcnt lgkmcnt(0)" ::: "memory")
DI float wave_sum(float v) {
#pragma unroll
    for (int o = 1; o < 64; o <<= 1) v += __shfl_xor(v, o);
    return v;
}
DI void p0_transpose_item(const float* W, int ldw, int srccol0, bf16_t* WT, int dstrow0, const float* g, LAS float* scr, int kb, int lane) {
    const int k0 = 64 * kb;
    float wv[32];
    const GAS float* Wg = (const GAS float*)W + (size_t)(k0 + (lane >> 5)) * ldw + srccol0 + (lane & 31);
#pragma unroll
    for (int i = 0; i < 32; ++i) wv[i] = Wg[(size_t)(2 * i) * ldw];
    const float g0 = g ? ((const GAS float*)g)[k0 + (lane & 63)] : 1.f;
#pragma unroll
    for (int i = 0; i < 32; ++i) { const int kk = 2 * i + (lane >> 5); const float sc = __shfl(g0, kk); scr[kk * 33 + (lane & 31)] = wv[i] * sc; }
    LDS_WAIT(); asm volatile("" ::: "memory");
    const int c = lane & 7;
#pragma unroll
    for (int j = 0; j < 4; ++j) { const int n = (lane >> 3) + 8 * j; const LAS float* s = scr + (8 * c) * 33 + n;
        u32x4 o; o.x = pk2(s[0 * 33], s[1 * 33]); o.y = pk2(s[2 * 33], s[3 * 33]); o.z = pk2(s[4 * 33], s[5 * 33]); o.w = pk2(s[6 * 33], s[7 * 33]);
        *(u32x4*)(WT + (size_t)(dstrow0 + n) * 1024 + k0 + 8 * c) = o; }
    LDS_WAIT(); asm volatile("" ::: "memory");
}
DI void rows4_to_bf16(const float* src, bf16_t* dst, float* ssq, int m0, int st, int lane) {
    f32x4 v[4][4]; float sq[4];
#pragma unroll
    for (int r = 0; r < 4; ++r) { const GAS f32x4* xr = (const GAS f32x4*)(src + (size_t)(m0 + r * st) * DM) + lane;
#pragma unroll
        for (int j = 0; j < 4; ++j) v[r][j] = xr[64 * j]; }
#pragma unroll
    for (int r = 0; r < 4; ++r) { sq[r] = 0.f;
#pragma unroll
        for (int j = 0; j < 4; ++j) sq[r] += (v[r][j].x * v[r][j].x + v[r][j].y * v[r][j].y) + (v[r][j].z * v[r][j].z + v[r][j].w * v[r][j].w);
        sq[r] = wave_sum(sq[r]);
        GAS u32x2* o8 = (GAS u32x2*)(dst + (size_t)(m0 + r * st) * DM) + lane;
#pragma unroll
        for (int j = 0; j < 4; ++j) { u32x2 w; w.x = pk2(v[r][j].x, v[r][j].y); w.y = pk2(v[r][j].z, v[r][j].w); o8[64 * j] = w; }
        if (lane == 0) ((GAS float*)ssq)[m0 + r * st] = sq[r]; }
}
DI int segmap(int c) {
    if (c < 384) return c;
    if (c < 768) return 1536 + (c - 384);
    if (c < 1024) return 2560 + (c - 768);
    if (c < 1408) return 384 + (c - 1024);
    if (c < 1536) return 1920 + (c - 1408);
    if (c < 1920) return 1152 + (c - 1536);
    if (c < 2304) return 2176 + (c - 1920);
    return 2816 + (c - 2304);
}

__global__ void __launch_bounds__(512, 2) hymba_fwd(Args a) {
    extern __shared__ __attribute__((aligned(16))) unsigned char lds_raw[];
    LAS unsigned char* lds = (LAS unsigned char*)lds_raw;
    cg::grid_group grid = cg::this_grid();
    const int wave = __builtin_amdgcn_readfirstlane((int)threadIdx.x >> 6);
    const int lane = lane_id(), tid = wave * 64 + lane;
    const int G = gridDim.x, bx = blockIdx.x;
    const int gw = bx * 8 + wave, NGW = G * 8;
    unsigned char* ws = a.ws;
    float* ROWSS = (float*)(ws + WS_ROWSS); float* MEMSS = (float*)(ws + WS_MEMSS);
    bf16_t* WIN = (bf16_t*)(ws + WS_WIN); bf16_t* WOUT = (bf16_t*)(ws + WS_WOUT); bf16_t* WMK = (bf16_t*)(ws + WS_WMK); bf16_t* WMV = (bf16_t*)(ws + WS_WMV);
    bf16_t* MEMB = (bf16_t*)(ws + WS_MEMB); bf16_t* MEMK = (bf16_t*)(ws + WS_MEMK); bf16_t* MEMVT = (bf16_t*)(ws + WS_MEMVT);
    bf16_t* XB = (bf16_t*)(ws + WS_XB); bf16_t* PROJ = (bf16_t*)(ws + WS_PROJ); bf16_t* VT = (bf16_t*)(ws + WS_VT);

#ifdef PROBE_SEL
    unsigned long long tq[4] = {0, 0, 0, 0}; unsigned long long tlast = __builtin_amdgcn_s_memrealtime();
#define STAMP(k) do { const unsigned long long tnow = __builtin_amdgcn_s_memrealtime(); tq[k] += tnow - tlast; tlast = tnow; } while (0)
#else
#define STAMP(k) do {} while (0)
#endif
    if (tid == 0) { ((volatile LAS unsigned*)(lds + LDS_BARST))[0] = 0u; ((volatile LAS unsigned*)(lds + LDS_BARST))[1] = 0u; }
    __syncthreads();
    const XcdBarrier xbar = xcd_barrier_post((unsigned*)(a.ws + WS_BAR), (volatile LAS unsigned*)(lds + LDS_BARST), tid == 0);
    {
        LAS float* scr = (LAS float*)(lds + wave * 16384);
        constexpr int I_IN = DEPTH * 96 * 16, I_OUT = DEPTH * 32 * 16, I_MK = DEPTH * 8 * 16, I_MV = I_MK, NITEMS = I_IN + I_OUT + I_MK + I_MV;
        for (int it = gw; it < NITEMS; it += NGW) {
            int r = it;
            if (r < I_IN) { const int l = r / 1536, rem = r % 1536, nb = rem >> 4, kb = rem & 15; int src;
                if (nb < 80) { const int R0 = 32 * nb, pn = R0 >> 8, p = R0 & 255, bj = p >> 7, hd = (p >> 5) & 3; src = segmap(256 * pn + 64 * hd + 32 * bj); }
                else { const int vr = 32 * (nb - 80); src = vr < 384 ? 768 + vr : 2048 + (vr - 384); }
                p0_transpose_item(a.w_in + (size_t)l * 1024 * 3072, 3072, src, WIN + (size_t)l * 3072 * 1024, 32 * nb, a.norm_g + l * 1024, scr, kb, lane); continue; }
            r -= I_IN;
            if (r < I_OUT) { const int l = r / 512, rem = r % 512, nb = rem >> 4, kb = rem & 15;
                p0_transpose_item(a.w_out + (size_t)l * 1024 * 1024, 1024, 32 * nb, WOUT + (size_t)l * 1024 * 1024, 32 * nb, nullptr, scr, kb, lane); continue; }
            r -= I_OUT;
            if (r < I_MK) { const int l = r / 128, rem = r % 128, nb = rem >> 4, kb = rem & 15; const int p = 32 * nb, bj = p >> 7, hd = (p >> 5) & 3;
                p0_transpose_item(a.w_mem_kv + (size_t)l * 1024 * 512, 512, 64 * hd + 32 * bj, WMK + (size_t)l * 256 * 1024, 32 * nb, a.mem_norm_g + l * 1024, scr, kb, lane); continue; }
            r -= I_MK;
            { const int l = r / 128, rem = r % 128, nb = rem >> 4, kb = rem & 15;
                p0_transpose_item(a.w_mem_kv + (size_t)l * 1024 * 512, 512, 256 + 32 * nb, WMV + (size_t)l * 256 * 1024, 32 * nb, a.mem_norm_g + l * 1024, scr, kb, lane); }
        }
        for (int m = gw; m < NTOK_P / 4; m += NGW) rows4_to_bf16(a.x_prompt, XB, ROWSS, m, NTOK_P / 4, lane);
        for (int m = gw; m < (NTOK - NTOK_P) / 4; m += NGW) rows4_to_bf16(a.x_sample, XB + (size_t)NTOK_P * DM, ROWSS + NTOK_P, m, (NTOK - NTOK_P) / 4, lane);
        for (int m = gw; m < 1024 / 4; m += NGW) rows4_to_bf16(a.mem_prompt, MEMB, MEMSS, m, 1024 / 4, lane);
        for (int m = gw; m < 4096 / 4; m += NGW) rows4_to_bf16(a.mem_sample, MEMB + (size_t)1024 * DM, MEMSS + 1024, m, 4096 / 4, lane);
        for (int i = bx * 512 + tid; i < 3 * NTOK; i += G * 512) ROWSS[NTOK + i] = 0.f;
        for (int i = bx * 512 + tid; i < DEPTH * 2880; i += G * 512) { const int ll = i / 2880, r0_ = i % 2880, h = r0_ / 480, rem = r0_ % 480, rr = rem >> 5, c = rem & 31;
            ((float*)(a.ws + WS_TAB))[i] = c < 31 ? a.rpb[(size_t)((ll * 6 + h) * 15 + rr) * 31 + c] * LOG2E : 0.f; }
    }
    if (a.ws == nullptr) grid.sync();
    xcd_barrier(xbar, wave);
    STAMP(0);

    {
        pg8::Gemm g{MEMB, WMK, NMEMTOK, 1024, 1024, 1024, 1024, 128, 128}; pg8::StaticOrder S; S.init(NMEMTOK, 1024, G, bx);
        pg8::EpiRow E{MEMK, 1024, MEMSS, a.q_norm_g, a.k_norm_g, 1, 0};
        pg8::gemm_phase<pg8::EpiRow, pg8::StaticOrder>(lds, g, S, E, wave);
    }
    {
        pg8::Gemm g{WMV, MEMB, 1024, NMEMTOK, 1024, 1024, 1024, 128, 128}; pg8::StaticOrder S; S.init(1024, NMEMTOK, G, (bx + 176) % G);
        pg8::EpiCol E{MEMVT, LDMVT, MEMSS, 0};
        pg8::gemm_phase<pg8::EpiCol, pg8::StaticOrder>(lds, g, S, E, wave);
    }

#pragma unroll 1
    for (int l = 0; l < DEPTH; ++l) {
        unsigned char* ws = a.ws; asm volatile("" : "+s"(ws));
        float* ROWSS = (float*)(ws + WS_ROWSS);
        bf16_t* WIN = (bf16_t*)(ws + WS_WIN); bf16_t* WOUT = (bf16_t*)(ws + WS_WOUT);
        bf16_t* MEMK = (bf16_t*)(ws + WS_MEMK); bf16_t* MEMVT = (bf16_t*)(ws + WS_MEMVT);
        bf16_t* XB = (bf16_t*)(ws + WS_XB); bf16_t* PROJ = (bf16_t*)(ws + WS_PROJ); bf16_t* VT = (bf16_t*)(ws + WS_VT);
        {
            pg8::Gemm g{XB, WIN + (size_t)l * 3072 * 1024, NTOK, 2560, 1024, 1024, 1024, 128, 128}; pg8::StaticOrder S; S.init(NTOK, 2560, G, bx);
            pg8::EpiRow E{PROJ, LDP, ROWSS + (size_t)l * NTOK, a.q_norm_g + l * 192, a.k_norm_g + l * 192, 0, 1};
            pg8::gemm_phase<pg8::EpiRow, pg8::StaticOrder>(lds, g, S, E, wave);
        }
        {
            pg8::Gemm g{WIN + (size_t)l * 3072 * 1024 + (size_t)2560 * 1024, XB, 512, NTOK, 1024, 1024, 1024, 128, 128}; pg8::StaticOrder S; S.init(512, NTOK, G, (bx + G / 2) % G);
            pg8::EpiCol E{VT, LDVT, ROWSS + (size_t)l * NTOK, 1};
            pg8::gemm_phase<pg8::EpiCol, pg8::StaticOrder>(lds, g, S, E, wave);
        }
        xcd_barrier(xbar, wave);
        STAMP(1);

        {
            int tid2 = wave * 64 + lane_id(); asm volatile("" : "+v"(tid2));
            const int tid = tid2, lane = tid & 63;
            LAS float* tab = (LAS float*)(lds + att::TAB_OFF);
            for (int i = tid; i < 720; i += 512) ((LAS f32x4*)tab)[i] = ((const GAS f32x4*)(ws + WS_TAB))[l * 720 + i];
            __syncthreads();
            LAS unsigned char* wl = lds + wave * 16384;
            const bool xcd_ok = (G == 256);
            const int xcd = xcd_ok ? (bx & 7) : 0, jw = xcd_ok ? ((bx >> 3) * 8 + wave) : gw, jstride = xcd_ok ? 256 : NGW;
            const int nA = xcd_ok ? 576 : 4608, nB = nA, nC = xcd_ok ? 384 : 3072;
            unsigned* qctr = (unsigned*)(a.ws + WS_CTR) + (l * 8 + xcd) * 64;
            for (int li = jw; li < nA + nB + nC; ) {
                unsigned nv = 0u;
                if (xcd_ok && lane == 0) nv = __hip_atomic_fetch_add(qctr, 1u, __ATOMIC_RELAXED, __HIP_MEMORY_SCOPE_AGENT);
                att::TaskP P;
                if (li < nA) {
                    const int task = xcd * nA + li;
                    const int h = task % 6, rr = task / 6;
                    int tokbase, r, rows;
                    if (rr < 256) { tokbase = (rr >> 6) * 4096; r = rr & 63; rows = 64; } else { const int r2 = rr - 256; tokbase = NTOK_P + (r2 >> 5) * 2048; r = r2 & 31; rows = 32; }
                    int r0 = r - 4; r0 = r0 < 0 ? 0 : (r0 > rows - 8 ? rows - 8 : r0);
                    const int qtok0 = tokbase + r * 64, key0 = tokbase + r0 * 64;
                    P.qrow_base = PROJ + ((size_t)h * NTOK + qtok0) * 64; P.grow_base = PROJ + ((size_t)(24 + h) * NTOK + qtok0) * 64;
                    P.kbase = PROJ + ((size_t)(16 + h) * NTOK + key0) * 64; P.ldk = 64;
                    P.vbase = VT + (size_t)(key0 >> 6) * 32768 + (h * 64) * 64; P.ldv = 64; P.vk32 = 0; P.nt = 16;
                    P.minit = -1e30f; P.linit = 0.f; P.rel_row0 = r0 - r + 7; P.tabh = h * 480 + (((r0 >> 1) & 3) << 12); P.dq0 = 0; P.jofs = 0; P.slope = 0.f;
                    att::attn_task<0>(P, tab, wl, lane);
                } else if (li < nA + nB) {
                    const int idx = xcd * nB + (li - nA), h = idx % 6, blk = idx / 6, tok0 = 64 * blk;
                    int tokbase, t0, T;
                    if (tok0 < NTOK_P) { tokbase = tok0 & ~4095; t0 = tok0 & 4095; T = 4096; } else { const int off = tok0 - NTOK_P; tokbase = NTOK_P + (off & ~2047); t0 = off & 2047; T = 2048; }
                    int jlo = 4 - (t0 >> 5); jlo = jlo < 0 ? 0 : jlo;
                    int jhi = ((T - t0) >> 5) + 3; jhi = jhi > 9 ? 9 : jhi;
                    const int sfirst = t0 - 128 + 32 * jlo, kvh = h / 3;
                    P.qrow_base = PROJ + ((size_t)(6 + h) * NTOK + tokbase + t0) * 64; P.grow_base = PROJ + ((size_t)(30 + h) * NTOK + tokbase + t0) * 64;
                    P.kbase = PROJ + ((size_t)(22 + kvh) * NTOK + tokbase + sfirst) * 64; P.ldk = 64;
                    P.vbase = VT + (384 + kvh * 64) * 64; P.ldv = 64; P.vk32 = (tokbase + sfirst) >> 5; P.nt = jhi - jlo + 1;
                    P.minit = a.sink[l * 6 + h] * LOG2E; P.linit = 1.f; P.rel_row0 = 0; P.tabh = 0;
                    P.dq0 = t0 - sfirst; P.jofs = jlo; P.slope = __builtin_amdgcn_exp2f(-8.0f * (float)(h + 1) / 6.0f) * LOG2E;
                    att::attn_task<1>(P, tab, wl, lane);
                } else {
                    const int idx = xcd * nC + (li - nA - nB), h = idx & 3, blk = idx >> 2, tok0 = 64 * blk;
                    const int bg = tok0 < NTOK_P ? (tok0 >> 12) : 4 + ((tok0 - NTOK_P) >> 11);
                    P.qrow_base = PROJ + ((size_t)(12 + h) * NTOK + tok0) * 64; P.grow_base = PROJ + ((size_t)(36 + h) * NTOK + tok0) * 64;
                    P.kbase = MEMK + (size_t)(bg * 256) * 1024 + l * 256 + h * 64; P.ldk = 1024;
                    P.vbase = MEMVT + (size_t)(l * 256 + h * 64) * LDMVT + bg * 256; P.ldv = LDMVT; P.vk32 = 0; P.nt = 8;
                    P.minit = -1e30f; P.linit = 0.f; P.rel_row0 = 0; P.tabh = 0; P.dq0 = 0; P.jofs = 0; P.slope = 0.f;
                    att::attn_task<2>(P, tab, wl, lane);
                }
                li = xcd_ok ? (int)(256u + (unsigned)__builtin_amdgcn_readfirstlane((int)nv)) : li + jstride;
            }
        }
        xcd_barrier(xbar, wave);
        STAMP(2);

        {
            pg8::Gemm g{PROJ, WOUT + (size_t)l * 1024 * 1024, NTOK, 1024, 1024, 64, 1024, PGRP * 2, 128}; pg8::StaticOrder S; S.init(NTOK, 1024, G, bx);
            pg8::EpiOut E{l == 0 ? a.x_prompt : a.out, l == 0 ? a.x_sample - (size_t)NTOK_P * DM : a.out, a.out, XB, ROWSS + (size_t)(l + 1 < DEPTH ? l + 1 : 0) * NTOK, l == DEPTH - 1 ? 1 : 0};
            pg8::gemm_phase<pg8::EpiOut, pg8::StaticOrder>(lds, g, S, E, wave);
        }
#ifdef PROBE_SEL
        grid.sync();
        STAMP(3);
#else
        if (l + 1 < DEPTH) xcd_barrier(xbar, wave);
#endif
    }
#ifdef PROBE_SEL
    if (bx == 0 && wave == 0 && lane_id() == 0) a.out[(size_t)NTOK_P * DM] += (float)tq[PROBE_SEL] * (0.01f / 50.0f);
#endif
}

extern "C" void kernel_launch(void* const* d_in, const int* in_sizes, int n_in, void* d_out, int out_size, void* d_ws, size_t ws_size, hipStream_t stream) {
    static int grid = 0;
    if (grid == 0) {
        if (n_in != 13 || ws_size < WS_END) { fprintf(stderr, "kernel_launch: unexpected n_in %d / ws %zu (need %zu)\n", n_in, ws_size, (size_t)WS_END); grid = -1; return; }
        int dev = 0, cus = 0, per_cu = 0;
        hipGetDevice(&dev);
        hipDeviceGetAttribute(&cus, hipDeviceAttributeMultiprocessorCount, dev);
        if (hipFuncSetAttribute((const void*)hymba_fwd, hipFuncAttributeMaxDynamicSharedMemorySize, LDS_BYTES) != hipSuccess) { fprintf(stderr, "kernel_launch: hipFuncSetAttribute failed\n"); grid = -1; return; }
        if (hipOccupancyMaxActiveBlocksPerMultiprocessor(&per_cu, (const void*)hymba_fwd, 512, LDS_BYTES) != hipSuccess || per_cu < 1) { fprintf(stderr, "kernel_launch: occupancy query failed (%d)\n", per_cu); (void)hipGetLastError(); per_cu = 1; }
        grid = cus * per_cu;
        fprintf(stderr, "kernel_launch: cus %d per_cu %d grid %d\n", cus, per_cu, grid);
    }
    if (grid < 0) return;
    Args a{};
    a.x_prompt = (const float*)d_in[0]; a.x_sample = (const float*)d_in[1]; a.mem_prompt = (const float*)d_in[2]; a.mem_sample = (const float*)d_in[3];
    a.norm_g = (const float*)d_in[4]; a.w_in = (const float*)d_in[5]; a.q_norm_g = (const float*)d_in[6]; a.k_norm_g = (const float*)d_in[7];
    a.rpb = (const float*)d_in[8]; a.sink = (const float*)d_in[9]; a.mem_norm_g = (const float*)d_in[10]; a.w_mem_kv = (const float*)d_in[11]; a.w_out = (const float*)d_in[12];
    a.out = (float*)d_out; a.ws = (unsigned char*)d_ws;
    if (hipMemsetAsync((char*)d_ws + WS_BAR, 0, XCD_BAR_WORDS * 4 + 32 * 256, stream) != hipSuccess) { fprintf(stderr, "kernel_launch: memset of the barrier words failed\n"); return; }
    void* args[] = {&a};
    hipError_t e = hipLaunchCooperativeKernel((const void*)hymba_fwd, dim3(grid), dim3(512), args, LDS_BYTES, stream);
    if (e != hipSuccess) fprintf(stderr, "kernel_launch: cooperative launch failed: %s (grid %d)\n", hipGetErrorString(e), grid);
}
```
